# Optimizing an MI355X kernel written in HIP

```python
import math
import jax, jax.numpy as jnp
from jax import lax
import numpy as np

D_MODEL = 1024
BATCH = 2
SEQ = 16384
DEPTH = 2

D_MIX = D_MODEL
D_CONV = D_MIX // 4
D_POOL = D_MIX // 4
D_ATTN = D_MIX // 2
N_HEADS = 4
HEAD_DIM = D_ATTN // (2 * N_HEADS)
V_DIM = 2 * HEAD_DIM
CONV_WIDTH = 31
POOL_WINDOWS = (2, 4, 8, 16)
N_POOL_GROUPS = len(POOL_WINDOWS)
POOL_GROUP_DIM = D_POOL // N_POOL_GROUPS
D_FF = 256 * ((8 * D_MODEL // 3 + 255) // 256)
D_IN = 2 * D_CONV + D_POOL + 3 * D_ATTN
Q_BLOCK = 128
NORM_EPS = 1e-6

kernel_name = "hybrid_conv_pool_diffattn_encoder"


def rms_norm(x, g):
    xf = x.astype(jnp.float32)
    y = xf * lax.rsqrt(jnp.mean(xf * xf, axis=-1, keepdims=True) + NORM_EPS)
    return (y * g.astype(jnp.float32)).astype(x.dtype)


def layer_norm(x, g, b):
    xf = x.astype(jnp.float32)
    mu = jnp.mean(xf, axis=-1, keepdims=True)
    xc = xf - mu
    y = xc * lax.rsqrt(jnp.mean(xc * xc, axis=-1, keepdims=True) + NORM_EPS)
    return (y * g.astype(jnp.float32) + b.astype(jnp.float32)).astype(x.dtype)


def swiglu_ffn(h, w_gate, w_up, w_down):
    return (jax.nn.silu(h @ w_gate) * (h @ w_up)) @ w_down


def conformer_conv(u, w_dw, b_dw, ln_g, ln_b):
    a, gate = jnp.split(u, 2, axis=-1)
    z = a * jax.nn.sigmoid(gate)
    z = lax.conv_general_dilated(
        z, w_dw[:, None, :], window_strides=(1,),
        padding=((CONV_WIDTH // 2, CONV_WIDTH // 2),),
        dimension_numbers=("NWC", "WIO", "NWC"),
        feature_group_count=D_CONV) + b_dw
    return jax.nn.silu(layer_norm(z, ln_g, ln_b))


def multiscale_pool(u, w_grp, scale):
    B_, S_, _ = u.shape
    uf = u.astype(jnp.float32)
    cs = jnp.concatenate([jnp.zeros((B_, 1, D_POOL), jnp.float32), jnp.cumsum(uf, axis=1)], axis=1)
    t = jnp.arange(S_, dtype=jnp.int32)
    outs = []
    for g, w in enumerate(POOL_WINDOWS):
        sl = slice(g * POOL_GROUP_DIM, (g + 1) * POOL_GROUP_DIM)
        lo = jnp.clip(t - w // 2, 0, S_)
        hi = jnp.clip(t + w // 2, 0, S_)
        csg = cs[..., sl]
        win_sum = jnp.take(csg, hi, axis=1) - jnp.take(csg, lo, axis=1)
        cnt = (hi - lo).astype(jnp.float32)[None, :, None]
        outs.append(win_sum / cnt - uf[..., sl])
    d = jnp.stack(outs, axis=2)
    y = jnp.einsum("bsgc,gcd->bsgd", d, w_grp.astype(jnp.float32)).reshape(B_, S_, D_POOL)
    return (y * scale.astype(jnp.float32)).astype(u.dtype)


def diff_attention(q, k, v, lam, slopes):
    B_, S_ = q.shape[0], q.shape[1]
    n_blk = S_ // Q_BLOCK
    q_blocks = jnp.moveaxis(q.reshape(B_, n_blk, Q_BLOCK, N_HEADS, 2, HEAD_DIM), 1, 0)
    k_pos = jnp.arange(S_, dtype=jnp.int32)

    def block(args):
        q_blk, blk = args
        q_pos = blk * Q_BLOCK + jnp.arange(Q_BLOCK, dtype=jnp.int32)
        dist = jnp.abs(q_pos[:, None] - k_pos[None, :]).astype(jnp.float32)
        s = jnp.einsum("bqhcd,bkhcd->bhcqk", q_blk, k, preferred_element_type=jnp.float32)
        s = s - slopes[None, :, None, None, None] * dist
        p = jax.nn.softmax(s, axis=-1)
        a = p[:, :, 0] - lam * p[:, :, 1]
        return jnp.einsum("bhqk,bkhe->bqhe", a.astype(v.dtype), v)

    o = lax.map(block, (q_blocks, jnp.arange(n_blk, dtype=jnp.int32)))
    return jnp.moveaxis(o, 0, 1).reshape(B_, S_, N_HEADS, V_DIM)


def setup_inputs(seed: int = 0) -> dict:
    key = jax.random.key(seed)
    ks = iter(jax.random.split(key, 32))

    def nrm(shape, scale):
        return jax.random.normal(next(ks), shape, jnp.float32) * scale

    def gain(shape):
        return 1.0 + 0.02 * jax.random.normal(next(ks), shape, jnp.float32)

    L = DEPTH
    return {
        "x": nrm((BATCH, SEQ, D_MODEL), 1.0),
        "ffn1_norm": gain((L, D_MODEL)),
        "ffn1_w_gate": nrm((L, D_MODEL, D_FF), D_MODEL ** -0.5),
        "ffn1_w_up": nrm((L, D_MODEL, D_FF), D_MODEL ** -0.5),
        "ffn1_w_down": nrm((L, D_FF, D_MODEL), D_FF ** -0.5),
        "mix_norm": gain((L, D_MODEL)),
        "w_in": nrm((L, D_MODEL, D_IN), D_MODEL ** -0.5),
        "conv_dw": nrm((L, CONV_WIDTH, D_CONV), CONV_WIDTH ** -0.5),
        "conv_dw_bias": nrm((L, D_CONV), 0.02),
        "conv_ln_gain": gain((L, D_CONV)),
        "conv_ln_bias": nrm((L, D_CONV), 0.02),
        "pool_w": nrm((L, N_POOL_GROUPS, POOL_GROUP_DIM, POOL_GROUP_DIM), POOL_GROUP_DIM ** -0.5),
        "pool_scale": 1.0 + 0.1 * jax.random.normal(next(ks), (L, D_POOL), jnp.float32),
        "q_norm": gain((L, HEAD_DIM)),
        "k_norm": gain((L, HEAD_DIM)),
        "lambda_q1": nrm((L, HEAD_DIM), 0.1),
        "lambda_k1": nrm((L, HEAD_DIM), 0.1),
        "lambda_q2": nrm((L, HEAD_DIM), 0.1),
        "lambda_k2": nrm((L, HEAD_DIM), 0.1),
        "attn_subln": gain((L, V_DIM)),
        "w_out": nrm((L, D_MIX, D_MODEL), D_MIX ** -0.5),
        "ffn2_norm": gain((L, D_MODEL)),
        "ffn2_w_gate": nrm((L, D_MODEL, D_FF), D_MODEL ** -0.5),
        "ffn2_w_up": nrm((L, D_MODEL, D_FF), D_MODEL ** -0.5),
        "ffn2_w_down": nrm((L, D_FF, D_MODEL), D_FF ** -0.5),
        "post_norm": gain((L, D_MODEL)),
    }


def reference(x, ffn1_norm, ffn1_w_gate, ffn1_w_up, ffn1_w_down, mix_norm, w_in,
              conv_dw, conv_dw_bias, conv_ln_gain, conv_ln_bias, pool_w, pool_scale,
              q_norm, k_norm, lambda_q1, lambda_k1, lambda_q2, lambda_k2, attn_subln,
              w_out, ffn2_norm, ffn2_w_gate, ffn2_w_up, ffn2_w_down, post_norm):
    B_, S_ = x.shape[0], x.shape[1]
    slopes = jnp.exp2(-8.0 * jnp.arange(1, N_HEADS + 1, dtype=jnp.float32) / N_HEADS)
    for l in range(DEPTH):
        lambda_init = 0.8 - 0.6 * math.exp(-0.3 * l)
        x = x + 0.5 * swiglu_ffn(rms_norm(x, ffn1_norm[l]), ffn1_w_gate[l], ffn1_w_up[l], ffn1_w_down[l])
        h = rms_norm(x, mix_norm[l])
        u = h @ w_in[l]
        u_conv = u[..., :2 * D_CONV]
        u_pool = u[..., 2 * D_CONV:2 * D_CONV + D_POOL]
        q, k, v = jnp.split(u[..., 2 * D_CONV + D_POOL:], 3, axis=-1)
        y_conv = conformer_conv(u_conv, conv_dw[l], conv_dw_bias[l], conv_ln_gain[l], conv_ln_bias[l])
        y_pool = multiscale_pool(u_pool, pool_w[l], pool_scale[l])
        q = rms_norm(q.reshape(B_, S_, N_HEADS, 2, HEAD_DIM), q_norm[l]) * (HEAD_DIM ** -0.5)
        k = rms_norm(k.reshape(B_, S_, N_HEADS, 2, HEAD_DIM), k_norm[l])
        v = v.reshape(B_, S_, N_HEADS, V_DIM)
        lam = (jnp.exp(jnp.sum(lambda_q1[l].astype(jnp.float32) * lambda_k1[l].astype(jnp.float32)))
               - jnp.exp(jnp.sum(lambda_q2[l].astype(jnp.float32) * lambda_k2[l].astype(jnp.float32)))
               + lambda_init)
        o = diff_attention(q, k, v, lam, slopes)
        y_attn = (rms_norm(o, attn_subln[l]) * (1.0 - lambda_init)).reshape(B_, S_, D_ATTN)
        y = jnp.concatenate([y_conv, y_pool, y_attn.astype(y_conv.dtype)], axis=-1) @ w_out[l]
        x = x + y
        x = x + 0.5 * swiglu_ffn(rms_norm(x, ffn2_norm[l]), ffn2_w_gate[l], ffn2_w_up[l], ffn2_w_down[l])
        x = rms_norm(x, post_norm[l])
    return x
```

```cpp
#include <hip/hip_runtime.h>
#include <hip/hip_cooperative_groups.h>
#include <cstdio>
#include <cstdint>
namespace cg = cooperative_groups;

#ifndef MK_SINGLE
#define MK_SINGLE 1
#endif
#ifndef ATT_FULL
#define ATT_FULL 0
#endif

#define LAS __attribute__((address_space(3)))
typedef unsigned short bf16_t;
typedef short bf16x8 __attribute__((ext_vector_type(8)));
typedef float f32x4 __attribute__((ext_vector_type(4)));
typedef float f32x2 __attribute__((ext_vector_type(2)));
typedef float f32x16 __attribute__((ext_vector_type(16)));
typedef unsigned u32x4 __attribute__((ext_vector_type(4)));
typedef unsigned u32x2 __attribute__((ext_vector_type(2)));
typedef __bf16 bf16x2_t __attribute__((ext_vector_type(2)));

constexpr int DM = 1024, NB = 2, SEQ = 16384, M = NB * SEQ, DFF = 2816, DIN = 2304, NLAYER = 2;
static_assert(NLAYER == 2, "lambda_init table below is for two layers");
constexpr int NHEAD = 4, HD = 64, VD = 128;
constexpr int VT_PITCH = M + 192;
constexpr float EPS = 1e-6f;
constexpr float LOG2E = 1.4426950408889634f;

__device__ __forceinline__ unsigned cvtpk(float lo, float hi) { f32x2 v = {lo, hi}; bf16x2_t b = __builtin_convertvector(v, bf16x2_t); return __builtin_bit_cast(unsigned, b); }
__device__ __forceinline__ float bf2f(bf16_t b) { return __uint_as_float(((unsigned)b) << 16); }
__device__ __forceinline__ float wave_sum(float v) {
#pragma unroll
    for (int o = 1; o < 64; o <<= 1) v += __shfl_xor(v, o);
    return v;
}
__device__ __forceinline__ float row_ss(const float* st, int row) { const f32x4* p = (const f32x4*)(st + (size_t)row * 16); const f32x4 a = p[0], b = p[1], c = p[2], d = p[3];
    return (((a[0] + a[1]) + (a[2] + a[3])) + ((b[0] + b[1]) + (b[2] + b[3]))) + (((c[0] + c[1]) + (c[2] + c[3])) + ((d[0] + d[1]) + (d[2] + d[3]))); }
__device__ __forceinline__ float fast_sigmoid(float g) { return __builtin_amdgcn_rcpf(1.0f + __builtin_amdgcn_exp2f(-g * LOG2E)); }

namespace pg8 {
constexpr int BM = 256, BK = 64, HALF = 128, HTB = HALF * BK * 2, STAGE_BYTES = 8 * HTB, NXCD = 8, WGM = 8;
__host__ __device__ __forceinline__ int lds_byte(int r, int c) { const int st = (r >> 4) * 2 + (c >> 5), rr = r & 15, cc = c & 31, ob = rr * 64 + cc * 2; return st * 1024 + (ob ^ (((ob >> 9) & 1) << 5)); }
__host__ __device__ __forceinline__ void stage_rc(int b, int& R, int& C) { const int st = b / 1024, sb = b % 1024, swz = sb ^ (((sb >> 9) & 1) << 5); R = (st >> 1) * 16 + swz / 64; C = (st & 1) * 32 + (swz % 64) / 2; }
__host__ __device__ __forceinline__ int perm32(int rho) { const int n = rho >> 4, i = rho & 15; return 8 * (i >> 2) + 4 * n + (i & 3); }

struct Unit { int pm, pn; };
struct Gemm { const bf16_t* A; const bf16_t* Bt; int M, N, K; };

struct StaticOrder {
    int nM, nN, nwg, G, c;
    __device__ void init(int M_, int N_, int G_, int c_) { nM = M_ / BM; nN = N_ / BM; nwg = nM * nN; G = G_; c = c_; asm volatile("" : "+s"(c), "+s"(G)); }
    __device__ bool next(int i, Unit& u) const {
        const long L = (long)i * G + c; if (L >= nwg) return false;
        int wgid = (int)L; { const int q = nwg / NXCD, r = nwg % NXCD, xcd = wgid % NXCD, off = wgid / NXCD; wgid = (xcd < r ? xcd * (q + 1) : r * (q + 1) + (xcd - r) * q) + off; }
        const int nig = WGM * nN, gid = wgid / nig, fm = gid * WGM, gsz = (nM - fm) < WGM ? (nM - fm) : WGM;
        u.pm = fm + ((wgid % nig) % gsz); u.pn = (wgid % nig) / gsz; return true;
    }
};

template <class Epi, class Sched, bool ALIGN_EPI = false, bool SP2 = false>
__device__ __forceinline__ void gemm_phase(LAS unsigned char* lds, const Gemm g, const Sched& S, const Epi& E) {
    int tid = threadIdx.x; asm volatile("" : "+v"(tid));
    const int wid = __builtin_amdgcn_readfirstlane(tid >> 6), lane = tid & 63, wr = wid >> 2, wc = wid & 3, fr = lane & 15, fq = lane >> 4;
    const int K = g.K, nt = K / BK;
    unsigned voffA[2], voffB[2];
#pragma unroll
    for (int i = 0; i < 2; ++i) { int R, C; stage_rc(tid * 16 + i * 8192, R, C); const int Rb = Epi::PERM ? ((R & ~31) + perm32(R & 31)) : R;
        voffA[i] = (unsigned)(R * K + C) * 2u; voffB[i] = (unsigned)(Rb * K + C) * 2u; }
    const size_t kstep = (size_t)(BK * 2);
    const size_t hstep = (size_t)HALF * K * 2;
    const size_t tstep = 2 * hstep;
    const unsigned ldsw = (unsigned)wid * 1024u;
    const int aoff = lds_byte(wr * 64 + fr, fq * 8), boff = lds_byte(wc * 32 + fr, fq * 8);
#define PG8_SA(b, h) (((b) * 2 + (h)) * HTB)
#define PG8_SB(b, h) ((4 + (b) * 2 + (h)) * HTB)
#define PG8_STAGE(bufoff, gbase, voff) do { _Pragma("unroll") for (int _i = 0; _i < 2; ++_i) \
        __builtin_amdgcn_global_load_lds((const unsigned*)((const char*)(gbase) + (voff)[_i]), (LAS unsigned*)(lds + (bufoff) + ldsw + _i * 8192), 16, 0, 0); } while (0)
#define PG8_LDA(dst, b, h) do { _Pragma("unroll") for (int m = 0; m < 4; ++m) _Pragma("unroll") for (int k = 0; k < 2; ++k) dst[m][k] = *(const LAS bf16x8*)(lds + PG8_SA(b, h) + aoff + m * 2048 + k * 1024); } while (0)
#define PG8_LDB(dst, b, h) do { _Pragma("unroll") for (int n = 0; n < 2; ++n) _Pragma("unroll") for (int k = 0; k < 2; ++k) dst[n][k] = *(const LAS bf16x8*)(lds + PG8_SB(b, h) + boff + n * 2048 + k * 1024); } while (0)
#define PG8_MMA(ai, bj, At, Bt) do { __builtin_amdgcn_s_setprio(1); _Pragma("unroll") for (int m = 0; m < 4; ++m) _Pragma("unroll") for (int n = 0; n < 2; ++n) _Pragma("unroll") for (int k = 0; k < 2; ++k) \
        acc[ai][bj][m][n] = __builtin_amdgcn_mfma_f32_16x16x32_bf16(Bt[n][k], At[m][k], acc[ai][bj][m][n], 0, 0, 0); __builtin_amdgcn_s_setprio(0); } while (0)
#define PG8_WAIT_V(n) asm volatile("s_waitcnt vmcnt(" #n ")" ::: "memory")
#define PG8_WAIT_L(n) asm volatile("s_waitcnt lgkmcnt(" #n ")" ::: "memory")
#define PG8_BAR __builtin_amdgcn_s_barrier()
#define PG8_SCHED __builtin_amdgcn_sched_barrier(0)
    Unit cur, nxt; int ui = 0;
    if (!S.next(0, cur)) return;
    f32x4 acc[2][2][4][2];
#pragma unroll
    for (int a = 0; a < 2; ++a)
#pragma unroll
        for (int b = 0; b < 2; ++b)
#pragma unroll
            for (int m = 0; m < 4; ++m)
#pragma unroll
                for (int n = 0; n < 2; ++n) acc[a][b][m][n] = (f32x4){0.f, 0.f, 0.f, 0.f};
    bf16x8 At[4][2], B0[2][2], B1[2][2];
    const char* cA = (const char*)g.A + (size_t)cur.pm * tstep; const char* cB = (const char*)g.Bt + (size_t)cur.pn * tstep;
    if constexpr (SP2) {
        PG8_STAGE(PG8_SB(0, 0), cB, voffB); PG8_STAGE(PG8_SB(0, 1), cB + hstep, voffB); PG8_STAGE(PG8_SA(0, 0), cA, voffA); PG8_STAGE(PG8_SA(0, 1), cA + hstep, voffA);
        if (wr == 1) PG8_BAR;
        PG8_WAIT_V(2); PG8_BAR;
        PG8_STAGE(PG8_SB(1, 0), cB + kstep, voffB); PG8_STAGE(PG8_SA(1, 0), cA + kstep, voffA); PG8_STAGE(PG8_SB(1, 1), cB + hstep + kstep, voffB);
        PG8_WAIT_V(6); PG8_BAR;
    } else {
        PG8_STAGE(PG8_SB(0, 0), cB, voffB); PG8_STAGE(PG8_SA(0, 0), cA, voffA); PG8_STAGE(PG8_SB(0, 1), cB + hstep, voffB); PG8_STAGE(PG8_SA(0, 1), cA + hstep, voffA);
        if (wr == 1) PG8_BAR;
        PG8_WAIT_V(4); PG8_BAR;
        PG8_STAGE(PG8_SB(1, 0), cB + kstep, voffB); PG8_STAGE(PG8_SA(1, 0), cA + kstep, voffA); PG8_STAGE(PG8_SB(1, 1), cB + hstep + kstep, voffB);
        PG8_WAIT_V(6); PG8_BAR;
    }
    for (;;) {
        const bool has_next = S.next(ui + 1, nxt);
        const char* nA = has_next ? (const char*)g.A + (size_t)nxt.pm * tstep : cA; const char* nB = has_next ? (const char*)g.Bt + (size_t)nxt.pn * tstep : cB;
        for (int t = 0; t < nt; t += 2) {
            const bool last = (t == nt - 2);
            const char* a1 = cA + (size_t)(t + 1) * kstep;
            const char* a2 = last ? nA : cA + (size_t)(t + 2) * kstep; const char* b2 = last ? nB : cB + (size_t)(t + 2) * kstep;
            const char* a3 = a2 + kstep; const char* b3 = b2 + kstep;
            if constexpr (SP2) {
            PG8_LDB(B0, 0, 0); PG8_LDB(B1, 0, 1); PG8_SCHED; PG8_LDA(At, 0, 0); PG8_STAGE(PG8_SA(1, 1), a1 + hstep, voffA);
            PG8_WAIT_V(8); PG8_WAIT_L(0); PG8_BAR; PG8_MMA(0, 0, At, B0); PG8_MMA(0, 1, At, B1); PG8_BAR; PG8_SCHED;
            PG8_LDA(At, 0, 1); PG8_STAGE(PG8_SB(0, 0), b2, voffB); PG8_STAGE(PG8_SB(0, 1), b2 + hstep, voffB); PG8_STAGE(PG8_SA(0, 0), a2, voffA);
            PG8_WAIT_V(8); PG8_WAIT_L(0); PG8_BAR; PG8_MMA(1, 0, At, B0); PG8_MMA(1, 1, At, B1); PG8_BAR; PG8_SCHED;
            PG8_LDB(B0, 1, 0); PG8_LDB(B1, 1, 1); PG8_SCHED; PG8_LDA(At, 1, 0); PG8_STAGE(PG8_SA(0, 1), a2 + hstep, voffA);
            PG8_WAIT_V(8); PG8_WAIT_L(0); PG8_BAR; PG8_MMA(0, 0, At, B0); PG8_MMA(0, 1, At, B1); PG8_BAR; PG8_SCHED;
            PG8_LDA(At, 1, 1); PG8_STAGE(PG8_SB(1, 0), b3, voffB); PG8_STAGE(PG8_SB(1, 1), b3 + hstep, voffB); PG8_STAGE(PG8_SA(1, 0), a3, voffA);
            PG8_WAIT_V(8); PG8_WAIT_L(0); PG8_BAR; PG8_MMA(1, 0, At, B0); PG8_MMA(1, 1, At, B1); PG8_BAR; PG8_SCHED;
            } else {
            PG8_LDB(B0, 0, 0); PG8_SCHED; PG8_LDA(At, 0, 0); PG8_STAGE(PG8_SA(1, 1), a1 + hstep, voffA);
            PG8_WAIT_L(8); PG8_BAR; PG8_WAIT_L(0); PG8_MMA(0, 0, At, B0); PG8_BAR; PG8_SCHED;
            PG8_LDB(B1, 0, 1); PG8_STAGE(PG8_SB(0, 0), b2, voffB);
            PG8_BAR; PG8_WAIT_L(0); PG8_MMA(0, 1, At, B1); PG8_BAR;
            PG8_LDA(At, 0, 1); PG8_STAGE(PG8_SA(0, 0), a2, voffA);
            PG8_BAR; PG8_WAIT_L(0); PG8_MMA(1, 0, At, B0); PG8_BAR; PG8_SCHED;
            PG8_STAGE(PG8_SB(0, 1), b2 + hstep, voffB);
            PG8_WAIT_V(6); PG8_BAR; PG8_MMA(1, 1, At, B1); PG8_BAR;
            PG8_LDB(B0, 1, 0); PG8_SCHED; PG8_LDA(At, 1, 0); PG8_STAGE(PG8_SA(0, 1), a2 + hstep, voffA);
            PG8_WAIT_L(8); PG8_BAR; PG8_WAIT_L(0); PG8_MMA(0, 0, At, B0); PG8_BAR; PG8_SCHED;
            PG8_LDB(B1, 1, 1); PG8_STAGE(PG8_SB(1, 0), b3, voffB);
            PG8_BAR; PG8_WAIT_L(0); PG8_MMA(0, 1, At, B1); PG8_BAR;
            PG8_LDA(At, 1, 1); PG8_STAGE(PG8_SA(1, 0), a3, voffA);
            PG8_BAR; PG8_WAIT_L(0); PG8_MMA(1, 0, At, B0); PG8_BAR; PG8_SCHED;
            PG8_STAGE(PG8_SB(1, 1), b3 + hstep, voffB);
            PG8_WAIT_V(6); PG8_BAR; PG8_MMA(1, 1, At, B1); PG8_BAR;
            }
        }
        if constexpr (ALIGN_EPI) { if (wr == 0) PG8_BAR; }
        E(acc, cur, wr, wc, fr, fq);
        if (!has_next) break;
#pragma unroll
        for (int a = 0; a < 2; ++a)
#pragma unroll
            for (int b = 0; b < 2; ++b)
#pragma unroll
                for (int m = 0; m < 4; ++m)
#pragma unroll
                    for (int n = 0; n < 2; ++n) acc[a][b][m][n] = (f32x4){0.f, 0.f, 0.f, 0.f};
        cur = nxt; cA = nA; cB = nB; ++ui;
        if constexpr (ALIGN_EPI) { if (wr == 1) PG8_BAR; }
    }
    PG8_WAIT_V(0);
    if constexpr (!ALIGN_EPI) { if (wr == 0) PG8_BAR; }
    PG8_BAR;
#undef PG8_SA
#undef PG8_SB
#undef PG8_STAGE
#undef PG8_LDA
#undef PG8_LDB
#undef PG8_MMA
#undef PG8_WAIT_V
#undef PG8_WAIT_L
#undef PG8_BAR
#undef PG8_SCHED
}

struct EpiBf16 {
    static constexpr bool PERM = true;
    bf16_t* O; int ldc; const float* cs;
    __device__ __forceinline__ void operator()(const f32x4 (&acc)[2][2][4][2], const Unit& u, int wr, int wc, int fr, int fq) const {
        const int row0 = u.pm * BM + wr * 64 + fr; const int col0 = u.pn * BM + wc * 32 + 8 * fq;
        f32x4 rs[2][2];
#pragma unroll
        for (int bj = 0; bj < 2; ++bj)
#pragma unroll
            for (int n = 0; n < 2; ++n)
#pragma unroll
                for (int e = 0; e < 4; ++e) rs[bj][n][e] = __builtin_amdgcn_rsqf(row_ss(cs, col0 + bj * HALF + 4 * n + e) * (1.0f / DM) + EPS);
#pragma unroll
        for (int ai = 0; ai < 2; ++ai)
#pragma unroll
            for (int m = 0; m < 4; ++m) { bf16_t* rowp = O + (size_t)(row0 + ai * HALF + m * 16) * ldc + col0;
#pragma unroll
                for (int bj = 0; bj < 2; ++bj) { const f32x4 v0 = acc[ai][bj][m][0] * rs[bj][0], v1 = acc[ai][bj][m][1] * rs[bj][1];
                    u32x4 w; w.x = cvtpk(v0[0], v0[1]); w.y = cvtpk(v0[2], v0[3]); w.z = cvtpk(v1[0], v1[1]); w.w = cvtpk(v1[2], v1[3]);
                    *(u32x4*)(rowp + bj * HALF) = w; } }
    }
};
struct EpiSwiGLU {
    static constexpr bool PERM = true;
    bf16_t* O; int ldc; const float* sa; const float* sb;
    __device__ __forceinline__ void operator()(const f32x4 (&acc)[2][2][4][2], const Unit& u, int wr, int wc, int fr, int fq) const {
        const int row0 = u.pm * BM + wr * 64 + fr; const int col0 = u.pn * HALF + wc * 32 + 8 * fq;
#pragma unroll
        for (int ai = 0; ai < 2; ++ai)
#pragma unroll
            for (int m = 0; m < 4; ++m) { const int row = row0 + ai * HALF + m * 16; bf16_t* rowp = O + (size_t)row * ldc + col0;
                float rs = __builtin_amdgcn_rsqf(row_ss(sa, row) * (1.0f / DM) + EPS);
                if (sb) rs *= __builtin_amdgcn_rsqf(rs * rs * row_ss(sb, row) * (1.0f / DM) + EPS);
                float o[8];
#pragma unroll
                for (int n = 0; n < 2; ++n)
#pragma unroll
                    for (int e = 0; e < 4; ++e) { const float gt = acc[ai][0][m][n][e] * rs, up = acc[ai][1][m][n][e] * rs; o[n * 4 + e] = gt * fast_sigmoid(gt) * up; }
                u32x4 w; w.x = cvtpk(o[0], o[1]); w.y = cvtpk(o[2], o[3]); w.z = cvtpk(o[4], o[5]); w.w = cvtpk(o[6], o[7]);
                *(u32x4*)rowp = w; }
    }
};
struct EpiResid {
    static constexpr bool PERM = true;
    const float* src32; bf16_t* xb; float alpha; const float* srs; const float* scg; float* st1; float* st2; const float* cg2;
    __device__ __forceinline__ void operator()(const f32x4 (&acc)[2][2][4][2], const Unit& u, int wr, int wc, int fr, int fq) const {
        const int row0 = u.pm * BM + wr * 64 + fr; const int col0 = u.pn * BM + wc * 32 + 8 * fq;
#pragma unroll
        for (int ai = 0; ai < 2; ++ai)
#pragma unroll
            for (int m = 0; m < 4; ++m) { const int row = row0 + ai * HALF + m * 16; const size_t off = (size_t)row * DM + col0;
                const float rsrc = srs ? __builtin_amdgcn_rsqf(row_ss(srs, row) * (1.0f / DM) + EPS) : 1.0f;
                float p1 = 0.f, p2 = 0.f;
#pragma unroll
                for (int bj = 0; bj < 2; ++bj) { const int co = bj * HALF;
                    f32x4 s0, s1;
                    if (src32) { s0 = *(const f32x4*)(src32 + off + co); s1 = *(const f32x4*)(src32 + off + co + 4); }
                    else { const u32x4 w = *(const u32x4*)(xb + off + co);
                        s0 = (f32x4){__uint_as_float(w.x << 16), __uint_as_float(w.x & 0xffff0000u), __uint_as_float(w.y << 16), __uint_as_float(w.y & 0xffff0000u)};
                        s1 = (f32x4){__uint_as_float(w.z << 16), __uint_as_float(w.z & 0xffff0000u), __uint_as_float(w.w << 16), __uint_as_float(w.w & 0xffff0000u)}; }
                    if (srs) { s0 = s0 * rsrc * *(const f32x4*)(scg + col0 + co); s1 = s1 * rsrc * *(const f32x4*)(scg + col0 + co + 4); }
                    const f32x4 v0 = s0 + acc[ai][bj][m][0] * alpha, v1 = s1 + acc[ai][bj][m][1] * alpha;
                    u32x4 wo; wo.x = cvtpk(v0[0], v0[1]); wo.y = cvtpk(v0[2], v0[3]); wo.z = cvtpk(v1[0], v1[1]); wo.w = cvtpk(v1[2], v1[3]);
                    *(u32x4*)(xb + off + co) = wo;
                    p1 += ((v0[0] * v0[0] + v0[1] * v0[1]) + (v0[2] * v0[2] + v0[3] * v0[3])) + ((v1[0] * v1[0] + v1[1] * v1[1]) + (v1[2] * v1[2] + v1[3] * v1[3]));
                    if (st2) { const f32x4 g0 = v0 * *(const f32x4*)(cg2 + col0 + co), g1 = v1 * *(const f32x4*)(cg2 + col0 + co + 4);
                        p2 += ((g0[0] * g0[0] + g0[1] * g0[1]) + (g0[2] * g0[2] + g0[3] * g0[3])) + ((g1[0] * g1[0] + g1[1] * g1[1]) + (g1[2] * g1[2] + g1[3] * g1[3])); } }
                p1 += __shfl_xor(p1, 16); p1 += __shfl_xor(p1, 32);
                if (st2) { p2 += __shfl_xor(p2, 16); p2 += __shfl_xor(p2, 32); }
                if (fq == 0) { const int slot = u.pn * 4 + wc; st1[(size_t)row * 16 + slot] = p1; if (st2) st2[(size_t)row * 16 + slot] = p2; }
                asm volatile("" ::: "memory"); }
    }
};
struct EpiIn {
    static constexpr bool PERM = true;
    bf16_t *Z, *UP, *Q, *Kb; const float *qg, *kg; const float* sa;
    __device__ __forceinline__ void operator()(const f32x4 (&acc)[2][2][4][2], const Unit& u, int wr, int wc, int fr, int fq) const {
        const int row0 = u.pm * BM + wr * 64 + fr;
        if (u.pn < 2) {
            const int col0 = u.pn * HALF + wc * 32 + 8 * fq;
#pragma unroll
            for (int ai = 0; ai < 2; ++ai)
#pragma unroll
                for (int m = 0; m < 4; ++m) { const int row = row0 + ai * HALF + m * 16; bf16_t* rowp = Z + (size_t)row * 256 + col0;
                    const float rs = __builtin_amdgcn_rsqf(row_ss(sa, row) * (1.0f / DM) + EPS);
                    float o[8];
#pragma unroll
                    for (int n = 0; n < 2; ++n)
#pragma unroll
                        for (int e = 0; e < 4; ++e) o[n * 4 + e] = acc[ai][0][m][n][e] * rs * fast_sigmoid(acc[ai][1][m][n][e] * rs);
                    u32x4 w; w.x = cvtpk(o[0], o[1]); w.y = cvtpk(o[2], o[3]); w.z = cvtpk(o[4], o[5]); w.w = cvtpk(o[6], o[7]);
                    *(u32x4*)rowp = w; }
        } else if (u.pn == 2) {
            const int col0 = wc * 32 + 8 * fq;
#pragma unroll
            for (int ai = 0; ai < 2; ++ai)
#pragma unroll
                for (int m = 0; m < 4; ++m) { const int row = row0 + ai * HALF + m * 16; bf16_t* rowp = UP + (size_t)row * 256 + col0;
                    const float rs = __builtin_amdgcn_rsqf(row_ss(sa, row) * (1.0f / DM) + EPS);
#pragma unroll
                    for (int bj = 0; bj < 2; ++bj) { const f32x4 v0 = acc[ai][bj][m][0] * rs, v1 = acc[ai][bj][m][1] * rs;
                        u32x4 w; w.x = cvtpk(v0[0], v0[1]); w.y = cvtpk(v0[2], v0[3]); w.z = cvtpk(v1[0], v1[1]); w.w = cvtpk(v1[2], v1[3]);
                        *(u32x4*)(rowp + bj * HALF) = w; } }
        } else {
            const bool isq = u.pn < 5; const int T = (u.pn - 3) & 1;
            bf16_t* O = isq ? Q : Kb; const float* gp = isq ? qg : kg; const float sc = isq ? (0.125f * LOG2E) : 1.0f;
            const int col0 = 256 * T + 64 * wc + 8 * fq;
#pragma unroll
            for (int ai = 0; ai < 2; ++ai)
#pragma unroll
                for (int m = 0; m < 4; ++m) {
                    const int row = row0 + ai * HALF + m * 16;
                    const float r0 = __builtin_amdgcn_rsqf(row_ss(sa, row) * (1.0f / DM) + EPS);
                    float ss = 0.f;
#pragma unroll
                    for (int bj = 0; bj < 2; ++bj)
#pragma unroll
                        for (int n = 0; n < 2; ++n) { const f32x4 v = acc[ai][bj][m][n]; ss += (v[0] * v[0] + v[1] * v[1]) + (v[2] * v[2] + v[3] * v[3]); }
                    ss += __shfl_xor(ss, 16); ss += __shfl_xor(ss, 32);
                    const float rs = __builtin_amdgcn_rsqf(ss * r0 * r0 * (1.0f / 64.0f) + EPS) * r0 * sc;
                    bf16_t* rowp = O + (size_t)row * 512 + col0;
#pragma unroll
                    for (int bj = 0; bj < 2; ++bj) { const f32x4 g0 = *(const f32x4*)(gp + 32 * bj + 8 * fq), g1 = *(const f32x4*)(gp + 32 * bj + 8 * fq + 4);
                        const f32x4 v0 = acc[ai][bj][m][0] * rs * g0, v1 = acc[ai][bj][m][1] * rs * g1;
                        u32x4 w; w.x = cvtpk(v0[0], v0[1]); w.y = cvtpk(v0[2], v0[3]); w.z = cvtpk(v1[0], v1[1]); w.w = cvtpk(v1[2], v1[3]);
                        *(u32x4*)(rowp + bj * 32) = w; }
                    asm volatile("" ::: "memory"); }
        }
    }
};
}

constexpr size_t MiB = 1u << 20;
constexpr size_t WS_CTL = 0;
constexpr size_t WS_W = 2 * MiB, W_LAYER = 40 * MiB;
constexpr size_t WO_GU1 = 0, WO_D1 = 11 * MiB, WO_IN = WO_D1 + 5 * MiB + 512 * 1024, WO_OUT = WO_IN + 4 * MiB + 512 * 1024, WO_GU2 = WO_OUT + 2 * MiB, WO_D2 = WO_GU2 + 11 * MiB;
static_assert(WO_D2 + 5 * MiB + 512 * 1024 <= W_LAYER, "weights");
constexpr size_t WS_XN = 96 * MiB, WS_Y = 160 * MiB, WS_HID = 224 * MiB;
constexpr size_t WS_Z = WS_HID, WS_UP = WS_HID + 16 * MiB, WS_Q = WS_HID + 32 * MiB, WS_K = WS_HID + 64 * MiB, WS_VT = WS_HID + 96 * MiB;
constexpr size_t WS_END = WS_HID + 176 * MiB;
constexpr size_t WS_ST = WS_END;
constexpr size_t WS_TOTAL = WS_ST + 9 * (size_t)M * 16 * 4;
constexpr int LDS_BYTES = 131072 + 1024;

__device__ __forceinline__ void tr_item(const float* src, int pitch, bf16_t* dst, int K, int k0, LAS float* scr, int lane, const float* ga, const float* gb) {
    float wv[32];
#pragma unroll
    for (int i = 0; i < 32; ++i) wv[i] = src[(size_t)(k0 + 2 * i + (lane >> 5)) * pitch + (lane & 31)];
#pragma unroll
    for (int i = 0; i < 32; ++i) { const int kk = 2 * i + (lane >> 5); float gs = ga ? ga[k0 + kk] : 1.0f; if (gb) gs *= gb[k0 + kk];
        scr[kk * 33 + (lane & 31)] = wv[i] * gs; }
    asm volatile("s_waitcnt lgkmcnt(0)" ::: "memory");
    const int c = lane & 7;
#pragma unroll
    for (int j = 0; j < 4; ++j) { const int n = (lane >> 3) + 8 * j; const LAS float* s = scr + (8 * c) * 33 + n;
        u32x4 o; o.x = cvtpk(s[0 * 33], s[1 * 33]); o.y = cvtpk(s[2 * 33], s[3 * 33]); o.z = cvtpk(s[4 * 33], s[5 * 33]); o.w = cvtpk(s[6 * 33], s[7 * 33]);
        *(u32x4*)(dst + (size_t)n * K + k0 + 8 * c) = o; }
    asm volatile("s_waitcnt lgkmcnt(0)" ::: "memory");
}
__device__ __forceinline__ int in_colmap(int rho0) {
    if (rho0 < 512) { const int T = rho0 >> 8, bj = (rho0 >> 7) & 1, i0 = rho0 & 127; return bj * 256 + 128 * T + i0; }
    if (rho0 < 768 || rho0 >= 1792) return rho0;
    const int loc = rho0 - 768, T = loc >> 8, bj = (loc >> 7) & 1, wc = (loc >> 5) & 3;
    return 768 + 256 * T + 64 * wc + 32 * bj;
}

struct Args { const float* in[26]; float* out; unsigned char* ws; int ph_lo, ph_hi; };

__device__ __forceinline__ void attn_unit(LAS unsigned char* lds, const bf16_t* __restrict__ Qg, const bf16_t* __restrict__ Kg, const bf16_t* __restrict__ Vtg, bf16_t* Y,
                                          int b, int h, int qb, float slope2, float lam, const float* subln, int layer, int W, float wthr1) {
    int tid = threadIdx.x; asm volatile("" : "+v"(tid));
    const int lane = tid & 63, wid = __builtin_amdgcn_readfirstlane(tid >> 6), c = wid >> 2, qw = wid & 3, r32 = lane & 31, hi = lane >> 5;
    const int q0 = qb * 128, qpos = q0 + 32 * qw + r32;
    const size_t rowbase = (size_t)b * SEQ;
    bf16x8 qf[4];
    { const bf16_t* qp = Qg + (rowbase + qpos) * 512 + h * 128 + c * 64 + hi * 8;
#pragma unroll
      for (int d0 = 0; d0 < 4; ++d0) qf[d0] = *(const bf16x8*)(qp + 16 * d0);
      asm volatile("s_waitcnt vmcnt(0)" ::: "memory");
#pragma unroll
      for (int d0 = 0; d0 < 4; ++d0) asm volatile("" : "+v"(qf[d0])); }
    int jlo = q0 - W; if (jlo < 0) jlo = 0; jlo &= ~63;
    int jhi = (q0 + 128 + W + 63) & ~63; if (jhi > SEQ) jhi = SEQ;
    const int nT = (jhi - jlo) >> 6;
    const int srow = lane >> 3;
    const int krow_s = 8 * wid + srow, kch_s = (lane & 7) ^ ((krow_s >> 1) & 7);
    const bf16_t* kgp = Kg + (rowbase + krow_s) * 512 + h * 128 + kch_s * 8;
    const int vrow_s = 8 * wid + srow, vch_s = (lane & 7) ^ ((vrow_s >> 1) & 7);
    const bf16_t* vgp = Vtg + (size_t)(h * 128 + vrow_s) * VT_PITCH + rowbase + vch_s * 8;
    const int pi = (r32 & ~12) | ((r32 & 4) << 1) | ((r32 & 8) >> 1);
    const int swk = (pi >> 1) & 7, swv = (r32 >> 1) & 7;
    const int kbase = c * 8192 + pi * 128, vbase = r32 * 128;
    const int kc0 = (hi ^ swk) << 4, vc0 = (hi ^ swv) << 4;

    f32x16 o[4];
#pragma unroll
    for (int i = 0; i < 4; ++i)
#pragma unroll
        for (int r = 0; r < 16; ++r) o[i][r] = 0.f;
    float lsum = 0.f;
#define ATT_DMA(T_, SLOT_) do { const int sl_ = (SLOT_) * 16384; const bf16_t* kp_ = kgp + (size_t)(T_) * 64 * 512; const bf16_t* vp_ = vgp + (T_) * 64; \
        __builtin_amdgcn_global_load_lds((const unsigned*)kp_, (LAS unsigned*)(lds + sl_ + wid * 1024), 16, 0, 0); \
        __builtin_amdgcn_global_load_lds((const unsigned*)(kp_ + 64), (LAS unsigned*)(lds + sl_ + 8192 + wid * 1024), 16, 0, 0); \
        __builtin_amdgcn_global_load_lds((const unsigned*)vp_, (LAS unsigned*)(lds + 65536 + sl_ + wid * 1024), 16, 0, 0); \
        __builtin_amdgcn_global_load_lds((const unsigned*)(vp_ + (size_t)64 * VT_PITCH), (LAS unsigned*)(lds + 65536 + sl_ + 8192 + wid * 1024), 16, 0, 0); } while (0)
#define SB() __builtin_amdgcn_sched_barrier(0)
#define ATT_SOFTMAX(S_, FB_, PA_, PB_) do { \
        _Pragma("unroll") for (int r = 0; r < 16; ++r) { const float tt = (FB_) + (float)(16 * (r >> 3) + (r & 7)); const float p = __builtin_amdgcn_exp2f(__builtin_fmaf(-slope2, __builtin_fabsf(tt), S_[r])); lsum += p; S_[r] = p; } \
        u32x4 w0_, w1_; \
        w0_.x = cvtpk(S_[0], S_[1]); w0_.y = cvtpk(S_[2], S_[3]); w0_.z = cvtpk(S_[4], S_[5]); w0_.w = cvtpk(S_[6], S_[7]); \
        w1_.x = cvtpk(S_[8], S_[9]); w1_.y = cvtpk(S_[10], S_[11]); w1_.z = cvtpk(S_[12], S_[13]); w1_.w = cvtpk(S_[14], S_[15]); \
        PA_ = __builtin_bit_cast(bf16x8, w0_); PB_ = __builtin_bit_cast(bf16x8, w1_); } while (0)
#define ATT_RDV(VF_, VB_, S4_) do { _Pragma("unroll") for (int db = 0; db < 4; ++db) VF_[db] = *(const LAS bf16x8*)((VB_) + db * 4096 + (vc0 ^ ((S4_) * 32))); } while (0)
#define ATT_PV(PA_, VF_) do { _Pragma("unroll") for (int db = 0; db < 4; ++db) o[db] = __builtin_amdgcn_mfma_f32_32x32x16_bf16(PA_, VF_[db], o[db], 0, 0, 0); } while (0)
    const float sl_lane = hi ? 0.0f : slope2;
    const float cl_lane = (float)(pi - 32 * qw);
    bf16x8 qaug;
    { u32x4 w_; w_.x = 0x3f803f80u; w_.y = cvtpk((float)r32, (float)r32); w_.z = 0u; w_.w = 0u; qaug = __builtin_bit_cast(bf16x8, w_); }
#define ATT_SPLIT(V_) cvtpk((V_), (V_) - __uint_as_float(cvtpk((V_), 0.0f) << 16))
#define ATT_STEP(MODE_) do { \
        const float fb0 = (float)(j0 + 8 * hi - qpos), fb1 = fb0 + 32.0f; \
        const LAS unsigned char* kb_ = lds + sl + kbase; const LAS unsigned char* vb_ = lds + 65536 + sl + vbase; \
        bf16x8 kf[4], kg[4], vf0[4], vf1[4], pa0, pa1, pa2, pa3; \
        f32x16 s0, s1; \
        SB(); \
        _Pragma("unroll") for (int d0 = 0; d0 < 4; ++d0) { kf[d0] = *(const LAS bf16x8*)(kb_ + (kc0 ^ (d0 * 32))); kg[d0] = *(const LAS bf16x8*)(kb_ + 4096 + (kc0 ^ (d0 * 32))); } \
        SB(); \
        _Pragma("unroll") for (int r = 0; r < 16; ++r) { s0[r] = 0.f; s1[r] = 0.f; } \
        if ((MODE_) != 0) { \
            const float v0_ = -(float)(MODE_) * sl_lane * ((float)(j0 - q0) + cl_lane), v1_ = v0_ - (float)(MODE_) * sl_lane * 32.0f; \
            const float sg_ = (float)(MODE_) * sl_lane; \
            u32x4 a0_, a1_; a0_.x = ATT_SPLIT(v0_); a1_.x = ATT_SPLIT(v1_); a0_.y = ATT_SPLIT(sg_); a1_.y = a0_.y; a0_.z = 0u; a0_.w = 0u; a1_.z = 0u; a1_.w = 0u; \
            s0 = __builtin_amdgcn_mfma_f32_32x32x16_bf16(__builtin_bit_cast(bf16x8, a0_), qaug, s0, 0, 0, 0); \
            s1 = __builtin_amdgcn_mfma_f32_32x32x16_bf16(__builtin_bit_cast(bf16x8, a1_), qaug, s1, 0, 0, 0); } \
        _Pragma("unroll") for (int d0 = 0; d0 < 4; ++d0) s0 = __builtin_amdgcn_mfma_f32_32x32x16_bf16(kf[d0], qf[d0], s0, 0, 0, 0); \
        _Pragma("unroll") for (int d0 = 0; d0 < 4; ++d0) s1 = __builtin_amdgcn_mfma_f32_32x32x16_bf16(kg[d0], qf[d0], s1, 0, 0, 0); \
        ATT_RDV(vf0, vb_, 0); \
        if ((MODE_) != 0) ATT_SOFTMAX_LIN(s0, pa0, pa1); else ATT_SOFTMAX(s0, fb0, pa0, pa1); \
        __builtin_amdgcn_sched_group_barrier(0x008, ((MODE_) != 0) ? 10 : 8, 0);        \
        __builtin_amdgcn_sched_group_barrier(0x100, 4, 0);                                \
        __builtin_amdgcn_sched_group_barrier(0x002, 80, 0);                               \
        SB(); \
        ATT_RDV(vf1, vb_, 1); ATT_PV(pa0, vf0); \
        SB(); \
        ATT_RDV(vf0, vb_, 2); ATT_PV(pa1, vf1); \
        SB(); \
        if ((MODE_) != 0) ATT_SOFTMAX_LIN(s1, pa2, pa3); else ATT_SOFTMAX(s1, fb1, pa2, pa3); \
        SB(); \
        ATT_RDV(vf1, vb_, 3); ATT_PV(pa2, vf0); \
        SB(); \
        ATT_PV(pa3, vf1); \
        SB(); } while (0)
#define ATT_SOFTMAX_LIN(S_, PA_, PB_) do { \
        _Pragma("unroll") for (int r = 0; r < 16; ++r) { const float p = __builtin_amdgcn_exp2f(S_[r]); lsum += p; S_[r] = p; } \
        u32x4 w0_, w1_; \
        w0_.x = cvtpk(S_[0], S_[1]); w0_.y = cvtpk(S_[2], S_[3]); w0_.z = cvtpk(S_[4], S_[5]); w0_.w = cvtpk(S_[6], S_[7]); \
        w1_.x = cvtpk(S_[8], S_[9]); w1_.y = cvtpk(S_[10], S_[11]); w1_.z = cvtpk(S_[12], S_[13]); w1_.w = cvtpk(S_[14], S_[15]); \
        PA_ = __builtin_bit_cast(bf16x8, w0_); PB_ = __builtin_bit_cast(bf16x8, w1_); } while (0)
    const int Tm0 = q0 >> 6;
    int Tlo = jlo >> 6, Thi = (jhi >> 6) - 1;
    int kl = 1, kr = 1, side = 0, phase2 = 0, swl = 0, swr = 0, swlu = -1;
#define ATT_GEN(OUT_) do { int o_ = -1; \
        if (phase2) { if (swl <= swlu) o_ = swl++; else if (swr <= Thi) o_ = swr++; } \
        else { const int lt_ = Tm0 - kl, rt_ = Tm0 + 1 + kr; const bool lok_ = lt_ >= Tlo, rok_ = rt_ <= Thi; \
            if (lok_ && (side == 0 || !rok_)) { o_ = lt_; ++kl; side = 1; } else if (rok_) { o_ = rt_; ++kr; side = 0; } } \
        OUT_ = o_; } while (0)
    int tq0 = Tm0, tq1 = Tm0 + 1, tq2, tq3;
    ATT_GEN(tq2); ATT_GEN(tq3);
    ATT_DMA(tq0, 0); ATT_DMA(tq1, 1); ATT_DMA((tq2 < 0 ? Tm0 : tq2), 2);
    const int kcp = (int)(3.0f / (slope2 * 64.0f)) + 1, ic = 2 + 2 * kcp;
    for (int i = 0; tq0 >= 0; ++i) {
        asm volatile("s_waitcnt vmcnt(8)" ::: "memory");
        __builtin_amdgcn_s_barrier();
        asm volatile("" ::: "memory");
        ATT_DMA((tq3 < 0 ? Tm0 : tq3), (i + 3) & 3);
        const int sl = (i & 3) * 16384;
        const int j0 = tq0 << 6;
        if (tq0 < Tm0) ATT_STEP(-1); else if (tq0 > Tm0 + 1) ATT_STEP(1); else ATT_STEP(0);
        tq0 = tq1; tq1 = tq2; tq2 = tq3; ATT_GEN(tq3);
        if (i + 1 == ic && tq0 >= 0) {
            float lr = lsum + __shfl_xor(lsum, 32);
#pragma unroll
            for (int m = 1; m < 32; m <<= 1) lr = __builtin_fminf(lr, __shfl_xor(lr, m));
            volatile LAS float* red = (volatile LAS float*)(lds + 131072 + 64);
            if (lane == 0) red[wid] = lr;
            asm volatile("s_waitcnt lgkmcnt(0)" ::: "memory"); __builtin_amdgcn_s_barrier(); asm volatile("" ::: "memory");
            float lm = red[0];
#pragma unroll
            for (int w8 = 1; w8 < 8; ++w8) lm = __builtin_fminf(lm, red[w8]);
            lm = __builtin_bit_cast(float, __builtin_amdgcn_readfirstlane(__builtin_bit_cast(int, lm)));
            const float wn = (wthr1 - __builtin_amdgcn_logf(lm)) / slope2 + 1.0f;
            if (wn < (float)W) { const int Wn = wn > 0.f ? (int)wn : 0;
                int jl2 = q0 - Wn; if (jl2 < 0) jl2 = 0; jl2 &= ~63; int jh2 = (q0 + 128 + Wn + 63) & ~63; if (jh2 > SEQ) jh2 = SEQ;
                if ((jl2 >> 6) > Tlo) Tlo = jl2 >> 6; if ((jh2 >> 6) - 1 < Thi) Thi = (jh2 >> 6) - 1; }
            phase2 = 1; swl = Tlo; swlu = Tm0 - kl; swr = Tm0 + 1 + kr;
        }
    }
    asm volatile("s_waitcnt vmcnt(0)" ::: "memory");
    __syncthreads();
#undef ATT_DMA
#undef ATT_GEN
#undef ATT_SOFTMAX
#undef ATT_SOFTMAX_LIN
#undef ATT_STEP
#undef ATT_SPLIT
#undef ATT_RDV
#undef ATT_PV
#undef SB
    lsum += __shfl_xor(lsum, 32);
    const float inv = 1.0f / lsum;
    float invr[16];
#pragma unroll
    for (int r = 0; r < 16; ++r) invr[r] = __shfl(inv, (r & 3) + 8 * (r >> 2) + 4 * hi);
    LAS float* X = (LAS float*)lds + qw * 4096;
    if (c == 1) {
#pragma unroll
        for (int db = 0; db < 4; ++db)
#pragma unroll
            for (int r = 0; r < 16; ++r) X[((r & 3) + 8 * (r >> 2) + 4 * hi) * 128 + 32 * db + r32] = o[db][r] * invr[r] * lam;
    }
    __syncthreads();
    if (c == 0) {
        float ss[16];
#pragma unroll
        for (int r = 0; r < 16; ++r) ss[r] = 0.f;
#pragma unroll
        for (int db = 0; db < 4; ++db)
#pragma unroll
            for (int r = 0; r < 16; ++r) { const float v = o[db][r] * invr[r] - X[((r & 3) + 8 * (r >> 2) + 4 * hi) * 128 + 32 * db + r32]; o[db][r] = v; ss[r] += v * v; }
#pragma unroll
        for (int r = 0; r < 16; ++r) {
#pragma unroll
            for (int m = 1; m < 32; m <<= 1) ss[r] += __shfl_xor(ss[r], m);
            ss[r] = __builtin_amdgcn_rsqf(ss[r] * (1.0f / 128.0f) + EPS) * (layer == 0 ? 0.8f : 0.64449093f);
        }
        asm volatile("s_waitcnt lgkmcnt(0)" ::: "memory");
        LAS bf16_t* Sg = (LAS bf16_t*)(lds + qw * 16384);
#pragma unroll
        for (int db = 0; db < 4; ++db) { const float g = subln[32 * db + r32];
#pragma unroll
            for (int r = 0; r < 16; ++r) { const unsigned pk = cvtpk(o[db][r] * ss[r] * g, 0.f); Sg[((r & 3) + 8 * (r >> 2) + 4 * hi) * 128 + 32 * db + r32] = (bf16_t)(pk & 0xffffu); } }
        asm volatile("s_waitcnt lgkmcnt(0)" ::: "memory");
        bf16_t* yb = Y + (rowbase + q0 + 32 * qw) * 1024 + 512 + h * 128;
#pragma unroll
        for (int i = 0; i < 8; ++i) { const int ch = lane + 64 * i, row = ch >> 4, cc = ch & 15; const u32x4 v = *(const LAS u32x4*)((LAS unsigned char*)Sg + row * 256 + cc * 16); *(u32x4*)(yb + (size_t)row * 1024 + cc * 8) = v; }
    }
    __syncthreads();
}

__device__ __forceinline__ void conv_unit(LAS unsigned char* lds, const bf16_t* __restrict__ Z, bf16_t* Y, int b, int t0, const float* wdw, const float* bdw, const float* lng, const float* lnb) {
    int tid = threadIdx.x; asm volatile("" : "+v"(tid));
    const int lane = tid & 63, wid = tid >> 6, c = tid & 255, half = tid >> 8;
    float w[31];
#pragma unroll
    for (int j = 0; j < 31; ++j) w[j] = wdw[j * 256 + c];
    float acc[32]; const float bias = bdw[c];
#pragma unroll
    for (int o = 0; o < 32; ++o) acc[o] = bias;
    const int tf = t0 + 32 * half - 15;
    const bf16_t* zb = Z + ((size_t)b * SEQ) * 256 + c;
#pragma unroll
    for (int i = 0; i < 62; ++i) {
        const int row = tf + i; const float z = (row >= 0 && row < SEQ) ? bf2f(zb[(size_t)row * 256]) : 0.f;
#pragma unroll
        for (int o = 0; o < 32; ++o) { const int j = i - o; if (j >= 0 && j <= 30) acc[o] = __builtin_fmaf(w[j], z, acc[o]); }
    }
    LAS float* T = (LAS float*)lds;
#pragma unroll
    for (int o = 0; o < 32; ++o) T[(32 * half + o) * 256 + c] = acc[o];
    __syncthreads();
    const f32x4 g4 = ((const f32x4*)lng)[lane], b4 = ((const f32x4*)lnb)[lane];
#pragma unroll
    for (int k = 0; k < 8; ++k) {
        const int tok = wid * 8 + k;
        const f32x4 v = *(const LAS f32x4*)(T + tok * 256 + 4 * lane);
        const float mean = wave_sum((v.x + v.y) + (v.z + v.w)) * (1.f / 256.f);
        const f32x4 d = v - mean;
        const float var = wave_sum((d.x * d.x + d.y * d.y) + (d.z * d.z + d.w * d.w)) * (1.f / 256.f);
        const float rs = __builtin_amdgcn_rsqf(var + EPS);
        f32x4 y = d * rs * g4 + b4;
        y.x *= fast_sigmoid(y.x); y.y *= fast_sigmoid(y.y); y.z *= fast_sigmoid(y.z); y.w *= fast_sigmoid(y.w);
        u32x2 wv; wv.x = cvtpk(y.x, y.y); wv.y = cvtpk(y.z, y.w);
        *(u32x2*)(Y + ((size_t)b * SEQ + t0 + tok) * 1024 + 4 * lane) = wv;
    }
    __syncthreads();
}

constexpr int POOL_TP = 260;
template <int HW> __device__ __forceinline__ void pool_diff(const bf16_t* __restrict__ ub, int tfirst, LAS float* T, int half, int c) {
    float r[47];
#pragma unroll
    for (int i = 0; i < 47; ++i) { const int row = tfirst - 8 + i; r[i] = (row >= 0 && row < SEQ && i >= 8 - HW && i < 8 + 32 + HW - 1) ? bf2f(ub[(size_t)row * 256]) : 0.f; }
#pragma unroll
    for (int o = 0; o < 32; ++o) {
        float s = 0.f;
#pragma unroll
        for (int k = -HW; k < HW; ++k) s += r[8 + o + k];
        const int t = tfirst + o; int lo = t - HW; if (lo < 0) lo = 0; int hi = t + HW; if (hi > SEQ) hi = SEQ;
        T[(32 * half + o) * POOL_TP + c] = s / (float)(hi - lo) - r[8 + o];
    }
}
__device__ __forceinline__ void pool_unit(LAS unsigned char* lds, const bf16_t* __restrict__ UP, bf16_t* Y, int b, int t0, const float* pw, const float* pscale) {
    int tid = threadIdx.x; asm volatile("" : "+v"(tid));
    LAS float* T = (LAS float*)lds;
    { const int c = tid & 255, half = tid >> 8, g = __builtin_amdgcn_readfirstlane(c >> 6);
      const bf16_t* ub = UP + ((size_t)b * SEQ) * 256 + c;
      const int tfirst = t0 + 32 * half;
      if (g == 0) pool_diff<1>(ub, tfirst, T, half, c);
      else if (g == 1) pool_diff<2>(ub, tfirst, T, half, c);
      else if (g == 2) pool_diff<4>(ub, tfirst, T, half, c);
      else pool_diff<8>(ub, tfirst, T, half, c); }
    const int lane = tid & 63, wid = __builtin_amdgcn_readfirstlane(tid >> 6), g = wid & 3, half = wid >> 2, r32 = lane & 31, hi = lane >> 5;
    bf16x8 bw[4][2];
#pragma unroll
    for (int ks = 0; ks < 4; ++ks)
#pragma unroll
        for (int nb = 0; nb < 2; ++nb) { const float* wp = pw + (size_t)(g * 64 + 16 * ks + 8 * hi) * 64 + 32 * nb + r32;
            u32x4 w; w.x = cvtpk(wp[0], wp[64]); w.y = cvtpk(wp[128], wp[192]); w.z = cvtpk(wp[256], wp[320]); w.w = cvtpk(wp[384], wp[448]);
            bw[ks][nb] = __builtin_bit_cast(bf16x8, w); }
    __syncthreads();
    f32x16 acc0, acc1;
#pragma unroll
    for (int r = 0; r < 16; ++r) { acc0[r] = 0.f; acc1[r] = 0.f; }
#pragma unroll
    for (int ks = 0; ks < 4; ++ks) {
        const LAS f32x4* dp = (const LAS f32x4*)(T + (32 * half + r32) * POOL_TP + 64 * g + 16 * ks + 8 * hi);
        const f32x4 d0 = dp[0], d1 = dp[1];
        u32x4 w; w.x = cvtpk(d0[0], d0[1]); w.y = cvtpk(d0[2], d0[3]); w.z = cvtpk(d1[0], d1[1]); w.w = cvtpk(d1[2], d1[3]);
        const bf16x8 af = __builtin_bit_cast(bf16x8, w);
        acc0 = __builtin_amdgcn_mfma_f32_32x32x16_bf16(af, bw[ks][0], acc0, 0, 0, 0);
        acc1 = __builtin_amdgcn_mfma_f32_32x32x16_bf16(af, bw[ks][1], acc1, 0, 0, 0);
    }
    const float sc0 = pscale[64 * g + r32], sc1 = pscale[64 * g + 32 + r32];
    bf16_t* yb = Y + ((size_t)b * SEQ + t0 + 32 * half) * 1024 + 256 + 64 * g + r32;
#pragma unroll
    for (int r = 0; r < 16; ++r) { const int tok = (r & 3) + 8 * (r >> 2) + 4 * hi;
        yb[(size_t)tok * 1024] = (bf16_t)(cvtpk(acc0[r] * sc0, 0.f) & 0xffffu);
        yb[(size_t)tok * 1024 + 32] = (bf16_t)(cvtpk(acc1[r] * sc1, 0.f) & 0xffffu); }
    __syncthreads();
}

#define XB_TMO      128
#define XB_XCNT(j)  (256  + 64 * (j))
#define XB_XSUB(j)  (1280 + 64 * (j))
#define XB_XGEN(j)  (2304 + 64 * (j))
#define XB_TOP      3328
#define XB_TOPGEN   3392
#define XCD_BAR_WORDS 3456
#define XB_SPIN_CAP (1u << 18)
__device__ __forceinline__ unsigned xb_ld(unsigned* p)              { return __hip_atomic_load(p, __ATOMIC_RELAXED, __HIP_MEMORY_SCOPE_AGENT); }
__device__ __forceinline__ unsigned xb_add(unsigned* p, unsigned v) { return __hip_atomic_fetch_add(p, v, __ATOMIC_RELAXED, __HIP_MEMORY_SCOPE_AGENT); }
__device__ __forceinline__ unsigned xb_xcc_id() { return (unsigned)__builtin_amdgcn_s_getreg((3 << 11) | 20) & 0xFu; }
#define XB_SPIN(cond, bar) do { unsigned _sp = 0; while (cond) { __builtin_amdgcn_s_sleep(1); \
    if ((++_sp & 255u) == 0u) { if (xb_ld(&(bar)[XB_TMO])) break; if (_sp > XB_SPIN_CAP) { atomicAdd(&(bar)[XB_TMO], 1u); break; } } } } while (0)
struct XcdBarrier { unsigned* bar; unsigned x; volatile LAS unsigned* st; };
__device__ __forceinline__ XcdBarrier xcd_barrier_post(unsigned* bar, volatile LAS unsigned* st) {
    XcdBarrier b; b.bar = bar; b.x = xb_xcc_id(); b.st = st;
    if (threadIdx.x == 0) (void)xb_add(&bar[XB_XCNT(b.x)], 1u);
    return b;
}
__device__ __forceinline__ void xcd_barrier_complete(unsigned* bar, unsigned x, unsigned& nloc, unsigned& nx) {
    const unsigned G = gridDim.x * gridDim.y * gridDim.z;
    unsigned sum, cnt, mine, sp = 0u;
    for (;;) {
        sum = 0u; cnt = 0u; mine = 0u;
#pragma unroll
        for (unsigned j = 0; j < 16; ++j) { const unsigned c = xb_ld(&bar[XB_XCNT(j)]); sum += c; cnt += (c > 0u) ? 1u : 0u; mine = (j == x) ? c : mine; }
        if (sum == G) break;
        __builtin_amdgcn_s_sleep(1);
        if ((++sp & 255u) == 0u) { if (xb_ld(&bar[XB_TMO])) break; if (sp > XB_SPIN_CAP) { atomicAdd(&bar[XB_TMO], 1u); break; } }
    }
    nloc = mine > 0u ? mine : 1u; nx = cnt > 0u ? cnt : 1u;
}
__device__ __forceinline__ void xcd_barrier(const XcdBarrier& b) {
    asm volatile("s_waitcnt vmcnt(0)" ::: "memory");
    __syncthreads();
    if (threadIdx.x == 0) {
        unsigned* bar = b.bar; unsigned bx = b.x; asm volatile("" : "+s"(bar), "+s"(bx));
        __builtin_amdgcn_s_waitcnt(0);
        unsigned nloc = b.st[0], nx = b.st[1];
        if (nloc == 0u) { xcd_barrier_complete(bar, bx, nloc, nx); b.st[0] = nloc; b.st[1] = nx; }
        const unsigned old = xb_add(&bar[XB_XSUB(bx)], 1u);
        const unsigned gen = old / nloc;
        if (old + 1u == (gen + 1u) * nloc) {
            __builtin_amdgcn_fence(__ATOMIC_RELEASE, "agent");
            asm volatile("s_waitcnt vmcnt(0)" ::: "memory");
            const unsigned og = xb_add(&bar[XB_TOP], 1u);
            const unsigned tg = og / nx;
            if (og + 1u == (tg + 1u) * nx) xb_add(&bar[XB_TOPGEN], 1u);
            else XB_SPIN(xb_ld(&bar[XB_TOPGEN]) == tg, bar);
            __builtin_amdgcn_fence(__ATOMIC_ACQUIRE, "agent");
            xb_add(&bar[XB_XGEN(bx)], 1u);
            asm volatile("s_waitcnt vmcnt(0)" ::: "memory");
        } else {
            XB_SPIN(xb_ld(&bar[XB_XGEN(bx)]) == gen, bar);
            __builtin_amdgcn_fence(__ATOMIC_ACQUIRE, "agent");
            asm volatile("s_waitcnt vmcnt(0)" ::: "memory");
        }
    }
    __syncthreads();
}

constexpr int N_ATT_UNITS = NHEAD * NB * (SEQ / 128), N_CONV_UNITS = M / 64, N_POOL_UNITS = M / 64, N_MIX_UNITS = N_ATT_UNITS + N_CONV_UNITS + N_POOL_UNITS;
constexpr int NPHASE = 2 + 7 * NLAYER;

__global__ void __launch_bounds__(512, 2) fwd_kernel(Args args) {
    extern __shared__ __attribute__((aligned(16))) unsigned char lds_raw[];
    LAS unsigned char* lds = (LAS unsigned char*)lds_raw;
    volatile LAS int* misc = (volatile LAS int*)(lds + 131072);
    const int tid = threadIdx.x, lane = tid & 63, wave = __builtin_amdgcn_readfirstlane(tid >> 6);
    const int G = gridDim.x, gw = blockIdx.x * 8 + wave, NGW = G * 8;
    unsigned char* ws = args.ws;
    unsigned* ctl = (unsigned*)(ws + WS_CTL);
    bf16_t* XN = (bf16_t*)(ws + WS_XN); bf16_t* Yb = (bf16_t*)(ws + WS_Y); bf16_t* HID = (bf16_t*)(ws + WS_HID);
    bf16_t* Zb = (bf16_t*)(ws + WS_Z); bf16_t* UPb = (bf16_t*)(ws + WS_UP); bf16_t* Qb = (bf16_t*)(ws + WS_Q); bf16_t* Kb = (bf16_t*)(ws + WS_K); bf16_t* Vt = (bf16_t*)(ws + WS_VT);
    float* X = args.out;
#if MK_SINGLE
#define IN_PH(k) true
#else
    const int lo = args.ph_lo, hi = args.ph_hi;
#define IN_PH(k) (lo <= (k) && (k) < hi)
#endif
#if MK_SINGLE
    if (tid < 16) misc[tid] = 0;
    if (blockIdx.x == 0) for (int i = tid; i < 8192; i += 512) __hip_atomic_store(ctl + i, 0u, __ATOMIC_RELAXED, __HIP_MEMORY_SCOPE_AGENT);
    __threadfence(); cg::this_grid().sync();
    XcdBarrier gbar = xcd_barrier_post(ctl + 1024, (volatile LAS unsigned*)(misc + 8));
#define SEAM(k) do { if (IN_PH(k) && IN_PH((k) + 1)) xcd_barrier(gbar); } while (0)
#else
    if (lo == 0 && blockIdx.x == 0 && tid < 64) ctl[tid] = 0u;
#define SEAM(k) do { } while (0)
#endif

    float* ST = (float*)(ws + WS_ST);
    if (IN_PH(0)) {
        LAS float* scr = (LAS float*)(lds + wave * 16384);
        constexpr int I_GU = 16 * 176, I_D = 44 * 32, I_IN = 16 * 72, I_OUT = 16 * 32, I_LAYER = 2 * I_GU + 2 * I_D + I_IN + I_OUT;
        for (int it = gw; it < NLAYER * I_LAYER; it += NGW) {
            const int l = it / I_LAYER; int r = it % I_LAYER;
            unsigned char* wl = ws + WS_W + (size_t)l * W_LAYER;
            if (r < 2 * I_GU) {
                const int second = r >= I_GU; if (second) r -= I_GU;
                const int kb = r / 176, nb = r % 176, rho0 = 32 * nb, T = rho0 >> 8, bj = (rho0 >> 7) & 1, i0 = rho0 & 127;
                const float* src = args.in[second ? (bj ? 23 : 22) : (bj ? 3 : 2)] + (size_t)l * DM * DFF + 128 * T + i0;
                const float* ga = args.in[second ? 21 : 1] + l * DM;
                const float* gb = (!second && l > 0) ? args.in[25] + (l - 1) * DM : nullptr;
                tr_item(src, DFF, (bf16_t*)(wl + (second ? WO_GU2 : WO_GU1)) + (size_t)rho0 * DM, DM, 64 * kb, scr, lane, ga, gb);
                continue;
            }
            r -= 2 * I_GU;
            if (r < 2 * I_D) {
                const int second = r >= I_D; if (second) r -= I_D;
                const int kb = r / 32, nb = r % 32, rho0 = 32 * nb;
                const float* src = args.in[second ? 24 : 4] + (size_t)l * DFF * DM + rho0;
                tr_item(src, DM, (bf16_t*)(wl + (second ? WO_D2 : WO_D1)) + (size_t)rho0 * DFF, DFF, 64 * kb, scr, lane, nullptr, nullptr);
                continue;
            }
            r -= 2 * I_D;
            if (r < I_IN) {
                const int kb = r / 72, nb = r % 72, rho0 = 32 * nb;
                const float* src = args.in[6] + (size_t)l * DM * DIN + in_colmap(rho0);
                tr_item(src, DIN, (bf16_t*)(wl + WO_IN) + (size_t)rho0 * DM, DM, 64 * kb, scr, lane, args.in[5] + l * DM, nullptr);
                continue;
            }
            r -= I_IN;
            { const int kb = r / 32, nb = r % 32, rho0 = 32 * nb;
              const float* src = args.in[20] + (size_t)l * DM * DM + rho0;
              tr_item(src, DM, (bf16_t*)(wl + WO_OUT) + (size_t)rho0 * DM, DM, 64 * kb, scr, lane, nullptr, nullptr); }
        }
        for (int m = gw; m < M; m += NGW) {
            int ln = lane; asm volatile("" : "+v"(ln));
            const f32x4* xr = (const f32x4*)(args.in[0] + (size_t)m * DM) + ln; u32x2* o8 = (u32x2*)(XN + (size_t)m * DM) + ln;
            float sq = 0.f;
#pragma unroll
            for (int j = 0; j < 4; ++j) { const f32x4 v = xr[64 * j]; sq += (v.x * v.x + v.y * v.y) + (v.z * v.z + v.w * v.w); u32x2 w; w.x = cvtpk(v.x, v.y); w.y = cvtpk(v.z, v.w); o8[64 * j] = w; }
            sq = wave_sum(sq);
            if (ln < 16) ST[(size_t)m * 16 + ln] = (ln == 0) ? sq : 0.f;
        }
    }
    SEAM(0);

    for (int l = 0; l < NLAYER; ++l) {
        const int pb = 1 + 7 * l;
        unsigned char* wl = ws + WS_W + (size_t)l * W_LAYER;
        const float lambda_init = (l == 0) ? 0.2f : 0.35550907f;
        float* st_mix = ST + (size_t)(1 + 4 * l) * M * 16; float* st_ffn2 = ST + (size_t)(2 + 4 * l) * M * 16; float* st_post = ST + (size_t)(3 + 4 * l) * M * 16; float* st_post2 = ST + (size_t)(4 + 4 * l) * M * 16;
        const float* st_prev = (l == 0) ? ST : ST + (size_t)(3 + 4 * (l - 1)) * M * 16;
        const float* st_prev2 = (l == 0) ? nullptr : ST + (size_t)(4 + 4 * (l - 1)) * M * 16;
        if (IN_PH(pb + 0)) {
            pg8::Gemm g{XN, (const bf16_t*)(wl + WO_GU1), M, 2 * DFF, DM}; pg8::StaticOrder S; S.init(M, 2 * DFF, G, (int)blockIdx.x);
            pg8::EpiSwiGLU E{HID, DFF, st_prev, st_prev2};
            pg8::gemm_phase<pg8::EpiSwiGLU, pg8::StaticOrder, true, true>(lds, g, S, E);
        }
        SEAM(pb + 0);
        if (IN_PH(pb + 1)) {
            pg8::Gemm g{HID, (const bf16_t*)(wl + WO_D1), M, DM, DFF}; pg8::StaticOrder S; S.init(M, DM, G, (int)blockIdx.x);
            pg8::EpiResid E{l == 0 ? args.in[0] : nullptr, XN, 0.5f, l == 0 ? nullptr : st_prev, l == 0 ? nullptr : args.in[25] + (l - 1) * DM, st_mix, nullptr, nullptr};
            pg8::gemm_phase<pg8::EpiResid, pg8::StaticOrder, true, true>(lds, g, S, E);
        }
        SEAM(pb + 1);
        if (IN_PH(pb + 2)) {
            { pg8::Gemm g{XN, (const bf16_t*)(wl + WO_IN), M, 1792, DM}; pg8::StaticOrder S; S.init(M, 1792, G, (int)blockIdx.x);
              pg8::EpiIn E{Zb, UPb, Qb, Kb, args.in[13] + l * HD, args.in[14] + l * HD, st_mix};
              pg8::gemm_phase<pg8::EpiIn, pg8::StaticOrder, true, true>(lds, g, S, E); }
            { pg8::Gemm g{(const bf16_t*)(wl + WO_IN) + (size_t)1792 * DM, XN, 512, M, DM}; pg8::StaticOrder S; S.init(512, M, G, (int)((blockIdx.x + G / 2) % G));
              pg8::EpiBf16 E{Vt, VT_PITCH, st_mix};
              pg8::gemm_phase<pg8::EpiBf16, pg8::StaticOrder, true, true>(lds, g, S, E); }
        }
        SEAM(pb + 2);
        if (IN_PH(pb + 3)) {
            float lam;
            { const float a = args.in[15][l * HD + lane] * args.in[16][l * HD + lane], bq = args.in[17][l * HD + lane] * args.in[18][l * HD + lane];
              lam = __expf(wave_sum(a)) - __expf(wave_sum(bq)) + lambda_init;
              lam = __builtin_bit_cast(float, __builtin_amdgcn_readfirstlane(__builtin_bit_cast(int, lam))); }
            float wthr;
            { float gq = __builtin_fabsf(args.in[13][l * HD + lane]), gk = __builtin_fabsf(args.in[14][l * HD + lane]);
#pragma unroll
              for (int o = 1; o < 64; o <<= 1) { gq = __builtin_fmaxf(gq, __shfl_xor(gq, o)); gk = __builtin_fmaxf(gk, __shfl_xor(gk, o)); }
              const float b2 = 8.0f * gq * gk * LOG2E * 1.03f;
              wthr = 2.0f * b2 + 14.0f + 25.0f;
              wthr = __builtin_bit_cast(float, __builtin_amdgcn_readfirstlane(__builtin_bit_cast(int, wthr))); }
            const float wthr1 = 0.5f * (wthr - 39.0f) + 39.0f;
            const unsigned myq = xb_xcc_id() & 7u;
            unsigned qoff = 0;
            for (;;) {
                if (tid == 0) {
                    int got = -1;
                    while (qoff < 8u) {
                        const unsigned q = (myq + qoff) & 7u;
                        const unsigned i = atomicAdd(ctl + 4608 + l * 512 + q * 64, 1u);
                        if (i < 256u) { got = (int)(q * 256u + i); break; }
                        ++qoff;
                    }
                    misc[0] = got; misc[1] = (int)qoff;
                }
                __syncthreads();
                const int idx = misc[0]; qoff = (unsigned)misc[1];
                __syncthreads();
                if (idx < 0) break;
                const int qx = idx >> 8, li = idx & 255;
                if (li < 128) {
                    const int h = 3 - (li >> 5), j = li & 31, xi = qx & 3;
                    const int ch = (j < 16) ? (xi == 0 ? 3 : xi == 1 ? 2 : xi == 2 ? 4 : 5) : (xi == 0 ? 0 : xi == 1 ? 1 : xi == 2 ? 7 : 6);
                    const int b = qx >> 2, qb = 16 * ch + (j & 15);
                    const float slope2 = exp2f(-2.0f * (float)(h + 1)) * LOG2E;
                    const float nlog = __builtin_fminf(14.0f, __builtin_amdgcn_logf(2.0f * (1.0f / (slope2 * 0.69314718f) + 1.0f)));
                    int W = SEQ;
                    if (!ATT_FULL) { const float wf = (wthr - 14.0f + nlog) / slope2 + 1.0f; W = wf < (float)SEQ ? (int)wf : SEQ; }
                    attn_unit(lds, Qb, Kb, Vt, Yb, b, h, qb, slope2, lam, args.in[19] + l * VD, l, W, wthr1 - 14.0f + nlog);
                } else if (li < 192) {
                    const int u = 64 * qx + (li - 128), b = u / (SEQ / 64), t0 = (u % (SEQ / 64)) * 64;
                    conv_unit(lds, Zb, Yb, b, t0, args.in[7] + l * 31 * 256, args.in[8] + l * 256, args.in[9] + l * 256, args.in[10] + l * 256);
                } else {
                    const int u = 64 * qx + (li - 192), b = u / (SEQ / 64), t0 = (u % (SEQ / 64)) * 64;
                    pool_unit(lds, UPb, Yb, b, t0, args.in[11] + l * 4 * 64 * 64, args.in[12] + l * 256);
                }
            }
        }
        SEAM(pb + 3);
        if (IN_PH(pb + 4)) {
            pg8::Gemm g{Yb, (const bf16_t*)(wl + WO_OUT), M, DM, DM}; pg8::StaticOrder S; S.init(M, DM, G, (int)blockIdx.x);
            pg8::EpiResid E{nullptr, XN, 1.0f, nullptr, nullptr, st_ffn2, nullptr, nullptr};
            pg8::gemm_phase<pg8::EpiResid, pg8::StaticOrder, true, true>(lds, g, S, E);
        }
        SEAM(pb + 4);
        if (IN_PH(pb + 5)) {
            pg8::Gemm g{XN, (const bf16_t*)(wl + WO_GU2), M, 2 * DFF, DM}; pg8::StaticOrder S; S.init(M, 2 * DFF, G, (int)blockIdx.x);
            pg8::EpiSwiGLU E{HID, DFF, st_ffn2, nullptr};
            pg8::gemm_phase<pg8::EpiSwiGLU, pg8::StaticOrder, true, true>(lds, g, S, E);
        }
        SEAM(pb + 5);
        if (IN_PH(pb + 6)) {
            pg8::Gemm g{HID, (const bf16_t*)(wl + WO_D2), M, DM, DFF}; pg8::StaticOrder S; S.init(M, DM, G, (int)blockIdx.x);
            pg8::EpiResid E{nullptr, XN, 0.5f, nullptr, nullptr, st_post, (l + 1 < NLAYER) ? st_post2 : nullptr, args.in[25] + l * DM};
            pg8::gemm_phase<pg8::EpiResid, pg8::StaticOrder, true, true>(lds, g, S, E);
        }
        SEAM(pb + 6);
    }
    if (IN_PH(NPHASE - 1)) {
        const float* stp = ST + (size_t)(3 + 4 * (NLAYER - 1)) * M * 16; const float* gp = args.in[25] + (NLAYER - 1) * DM;
        for (int m = gw; m < M; m += NGW) {
            int ln = lane; asm volatile("" : "+v"(ln));
            const float rs = __builtin_amdgcn_rsqf(row_ss(stp, m) * (1.0f / DM) + EPS);
            const u32x2* xr = (const u32x2*)(XN + (size_t)m * DM) + ln; f32x4* orow = (f32x4*)(X + (size_t)m * DM) + ln;
#pragma unroll
            for (int j = 0; j < 4; ++j) { const u32x2 w = xr[64 * j];
                const f32x4 v = (f32x4){__uint_as_float(w.x << 16), __uint_as_float(w.x & 0xffff0000u), __uint_as_float(w.y << 16), __uint_as_float(w.y & 0xffff0000u)};
                orow[64 * j] = v * rs * ((const f32x4*)gp)[ln + 64 * j]; }
        }
    }
}

extern "C" void kernel_launch(void* const* d_in, const int* in_sizes, int n_in, void* d_out, int out_size, void* d_ws, size_t ws_size, hipStream_t stream) {
    static int grid = 0;
    if (grid == 0) {
        if (n_in != 26 || in_sizes[0] != M * DM || out_size != M * DM || ws_size < WS_TOTAL) { fprintf(stderr, "kernel_launch: unexpected problem shape (n_in %d, ws %zu)\n", n_in, ws_size); grid = -1; return; }
        int dev = 0, cus = 0, per_cu = 0;
        hipGetDevice(&dev); hipDeviceGetAttribute(&cus, hipDeviceAttributeMultiprocessorCount, dev);
        if (hipFuncSetAttribute((const void*)fwd_kernel, hipFuncAttributeMaxDynamicSharedMemorySize, LDS_BYTES) != hipSuccess) { fprintf(stderr, "kernel_launch: hipFuncSetAttribute failed\n"); grid = -1; return; }
        if (hipOccupancyMaxActiveBlocksPerMultiprocessor(&per_cu, (const void*)fwd_kernel, 512, LDS_BYTES) != hipSuccess || per_cu < 1) { fprintf(stderr, "kernel_launch: occupancy query says %d\n", per_cu); per_cu = 1; }
        (void)hipGetLastError();
        grid = cus;
    }
    if (grid < 0) return;
    Args a{};
    for (int i = 0; i < 26; ++i) a.in[i] = (const float*)d_in[i];
    a.out = (float*)d_out; a.ws = (unsigned char*)d_ws;
#if MK_SINGLE
    a.ph_lo = 0; a.ph_hi = NPHASE;
    void* kargs[] = {&a};
    hipError_t e = hipLaunchCooperativeKernel((const void*)fwd_kernel, dim3(grid), dim3(512), kargs, LDS_BYTES, stream);
    if (e != hipSuccess) fprintf(stderr, "cooperative launch failed: %s (grid %d)\n", hipGetErrorString(e), grid);
#else
    for (int p = 0; p < NPHASE; ++p) { a.ph_lo = p; a.ph_hi = p + 1; hipLaunchKernelGGL(fwd_kernel, dim3(grid), dim3(512), LDS_BYTES, stream, a); }
#endif
}
```

```cpp
#include <hip/hip_runtime.h>
#include <hip/hip_cooperative_groups.h>
#include <cstdio>
#include <cstdint>
namespace cg = cooperative_groups;

#ifndef MK_SINGLE
#define MK_SINGLE 1
#endif
#ifndef ATT_FULL
#define ATT_FULL 0
#endif

#define LAS __attribute__((address_space(3)))
typedef unsigned short bf16_t;
typedef short bf16x8 __attribute__((ext_vector_type(8)));
typedef float f32x4 __attribute__((ext_vector_type(4)));
typedef float f32x2 __attribute__((ext_vector_type(2)));
typedef float f32x16 __attribute__((ext_vector_type(16)));
typedef unsigned u32x4 __attribute__((ext_vector_type(4)));
typedef unsigned u32x2 __attribute__((ext_vector_type(2)));
typedef __bf16 bf16x2_t __attribute__((ext_vector_type(2)));

constexpr int DM = 1024, NB = 2, SEQ = 16384, M = NB * SEQ, DFF = 2816, DIN = 2304, NLAYER = 2;
static_assert(NLAYER == 2, "lambda_init table below is for two layers");
constexpr int NHEAD = 4, HD = 64, VD = 128;
constexpr int VT_PITCH = M + 192;
constexpr float EPS = 1e-6f;
constexpr float LOG2E = 1.4426950408889634f;

__device__ __forceinline__ unsigned cvtpk(float lo, float hi) { f32x2 v = {lo, hi}; bf16x2_t b = __builtin_convertvector(v, bf16x2_t); return __builtin_bit_cast(unsigned, b); }
__device__ __forceinline__ float bf2f(bf16_t b) { return __uint_as_float(((unsigned)b) << 16); }
__device__ __forceinline__ float wave_sum(float v) {
#pragma unroll
    for (int o = 1; o < 64; o <<= 1) v += __shfl_xor(v, o);
    return v;
}
__device__ __forceinline__ float row_ss(const float* st, int row) { const f32x4* p = (const f32x4*)(st + (size_t)row * 16); const f32x4 a = p[0], b = p[1], c = p[2], d = p[3];
    return (((a[0] + a[1]) + (a[2] + a[3])) + ((b[0] + b[1]) + (b[2] + b[3]))) + (((c[0] + c[1]) + (c[2] + c[3])) + ((d[0] + d[1]) + (d[2] + d[3]))); }
__device__ __forceinline__ float fast_sigmoid(float g) { return __builtin_amdgcn_rcpf(1.0f + __builtin_amdgcn_exp2f(-g * LOG2E)); }

namespace pg8 {
constexpr int BM = 256, BK = 64, HALF = 128, HTB = HALF * BK * 2, STAGE_BYTES = 8 * HTB, NXCD = 8, WGM = 8;
__host__ __device__ __forceinline__ int lds_byte(int r, int c) { const int st = (r >> 4) * 2 + (c >> 5), rr = r & 15, cc = c & 31, ob = rr * 64 + cc * 2; return st * 1024 + (ob ^ (((ob >> 9) & 1) << 5)); }
__host__ __device__ __forceinline__ void stage_rc(int b, int& R, int& C) { const int st = b / 1024, sb = b % 1024, swz = sb ^ (((sb >> 9) & 1) << 5); R = (st >> 1) * 16 + swz / 64; C = (st & 1) * 32 + (swz % 64) / 2; }
__host__ __device__ __forceinline__ int perm32(int rho) { const int n = rho >> 4, i = rho & 15; return 8 * (i >> 2) + 4 * n + (i & 3); }

struct Unit { int pm, pn; };
struct Gemm { const bf16_t* A; const bf16_t* Bt; int M, N, K; };

struct StaticOrder {
    int nM, nN, nwg, G, c;
    __device__ void init(int M_, int N_, int G_, int c_) { nM = M_ / BM; nN = N_ / BM; nwg = nM * nN; G = G_; c = c_; asm volatile("" : "+s"(c), "+s"(G)); }
    __device__ bool next(int i, Unit& u) const {
        const long L = (long)i * G + c; if (L >= nwg) return false;
        int wgid = (int)L; { const int q = nwg / NXCD, r = nwg % NXCD, xcd = wgid % NXCD, off = wgid / NXCD; wgid = (xcd < r ? xcd * (q + 1) : r * (q + 1) + (xcd - r) * q) + off; }
        const int nig = WGM * nN, gid = wgid / nig, fm = gid * WGM, gsz = (nM - fm) < WGM ? (nM - fm) : WGM;
        u.pm = fm + ((wgid % nig) % gsz); u.pn = (wgid % nig) / gsz; return true;
    }
};

template <class Epi, class Sched, bool ALIGN_EPI = false, bool SP2 = false>
__device__ __forceinline__ void gemm_phase(LAS unsigned char* lds, const Gemm g, const Sched& S, const Epi& E) {
    int tid = threadIdx.x; asm volatile("" : "+v"(tid));
    const int wid = __builtin_amdgcn_readfirstlane(tid >> 6), lane = tid & 63, wr = wid >> 2, wc = wid & 3, fr = lane & 15, fq = lane >> 4;
    const int K = g.K, nt = K / BK;
    unsigned voffA[2], voffB[2];
#pragma unroll
    for (int i = 0; i < 2; ++i) { int R, C; stage_rc(tid * 16 + i * 8192, R, C); const int Rb = Epi::PERM ? ((R & ~31) + perm32(R & 31)) : R;
        voffA[i] = (unsigned)(R * K + C) * 2u; voffB[i] = (unsigned)(Rb * K + C) * 2u; }
    const size_t kstep = (size_t)(BK * 2);
    const size_t hstep = (size_t)HALF * K * 2;
    const size_t tstep = 2 * hstep;
    const unsigned ldsw = (unsigned)wid * 1024u;
    const int aoff = lds_byte(wr * 64 + fr, fq * 8), boff = lds_byte(wc * 32 + fr, fq * 8);
#define PG8_SA(b, h) (((b) * 2 + (h)) * HTB)
#define PG8_SB(b, h) ((4 + (b) * 2 + (h)) * HTB)
#define PG8_STAGE(bufoff, gbase, voff) do { _Pragma("unroll") for (int _i = 0; _i < 2; ++_i) \
        __builtin_amdgcn_global_load_lds((const unsigned*)((const char*)(gbase) + (voff)[_i]), (LAS unsigned*)(lds + (bufoff) + ldsw + _i * 8192), 16, 0, 0); } while (0)
#define PG8_LDA(dst, b, h) do { _Pragma("unroll") for (int m = 0; m < 4; ++m) _Pragma("unroll") for (int k = 0; k < 2; ++k) dst[m][k] = *(const LAS bf16x8*)(lds + PG8_SA(b, h) + aoff + m * 2048 + k * 1024); } while (0)
#define PG8_LDB(dst, b, h) do { _Pragma("unroll") for (int n = 0; n < 2; ++n) _Pragma("unroll") for (int k = 0; k < 2; ++k) dst[n][k] = *(const LAS bf16x8*)(lds + PG8_SB(b, h) + boff + n * 2048 + k * 1024); } while (0)
#define PG8_MMA(ai, bj, At, Bt) do { __builtin_amdgcn_s_setprio(1); _Pragma("unroll") for (int m = 0; m < 4; ++m) _Pragma("unroll") for (int n = 0; n < 2; ++n) _Pragma("unroll") for (int k = 0; k < 2; ++k) \
        acc[ai][bj][m][n] = __builtin_amdgcn_mfma_f32_16x16x32_bf16(Bt[n][k], At[m][k], acc[ai][bj][m][n], 0, 0, 0); __builtin_amdgcn_s_setprio(0); } while (0)
#define PG8_WAIT_V(n) asm volatile("s_waitcnt vmcnt(" #n ")" ::: "memory")
#define PG8_WAIT_L(n) asm volatile("s_waitcnt lgkmcnt(" #n ")" ::: "memory")
#define PG8_BAR __builtin_amdgcn_s_barrier()
#define PG8_SCHED __builtin_amdgcn_sched_barrier(0)
    Unit cur, nxt; int ui = 0;
    if (!S.next(0, cur)) return;
    f32x4 acc[2][2][4][2];
#pragma unroll
    for (int a = 0; a < 2; ++a)
#pragma unroll
        for (int b = 0; b < 2; ++b)
#pragma unroll
            for (int m = 0; m < 4; ++m)
#pragma unroll
                for (int n = 0; n < 2; ++n) acc[a][b][m][n] = (f32x4){0.f, 0.f, 0.f, 0.f};
    bf16x8 At[4][2], B0[2][2], B1[2][2];
    const char* cA = (const char*)g.A + (size_t)cur.pm * tstep; const char* cB = (const char*)g.Bt + (size_t)cur.pn * tstep;
    if constexpr (SP2) {
        PG8_STAGE(PG8_SB(0, 0), cB, voffB); PG8_STAGE(PG8_SB(0, 1), cB + hstep, voffB); PG8_STAGE(PG8_SA(0, 0), cA, voffA); PG8_STAGE(PG8_SA(0, 1), cA + hstep, voffA);
        if (wr == 1) PG8_BAR;
        PG8_WAIT_V(2); PG8_BAR;
        PG8_STAGE(PG8_SB(1, 0), cB + kstep, voffB); PG8_STAGE(PG8_SA(1, 0), cA + kstep, voffA); PG8_STAGE(PG8_SB(1, 1), cB + hstep + kstep, voffB);
        PG8_WAIT_V(6); PG8_BAR;
    } else {
        PG8_STAGE(PG8_SB(0, 0), cB, voffB); PG8_STAGE(PG8_SA(0, 0), cA, voffA); PG8_STAGE(PG8_SB(0, 1), cB + hstep, voffB); PG8_STAGE(PG8_SA(0, 1), cA + hstep, voffA);
        if (wr == 1) PG8_BAR;
        PG8_WAIT_V(4); PG8_BAR;
        PG8_STAGE(PG8_SB(1, 0), cB + kstep, voffB); PG8_STAGE(PG8_SA(1, 0), cA + kstep, voffA); PG8_STAGE(PG8_SB(1, 1), cB + hstep + kstep, voffB);
        PG8_WAIT_V(6); PG8_BAR;
    }
    for (;;) {
        const bool has_next = S.next(ui + 1, nxt);
        const char* nA = has_next ? (const char*)g.A + (size_t)nxt.pm * tstep : cA; const char* nB = has_next ? (const char*)g.Bt + (size_t)nxt.pn * tstep : cB;
        for (int t = 0; t < nt; t += 2) {
            const bool last = (t == nt - 2);
            const char* a1 = cA + (size_t)(t + 1) * kstep;
            const char* a2 = last ? nA : cA + (size_t)(t + 2) * kstep; const char* b2 = last ? nB : cB + (size_t)(t + 2) * kstep;
            const char* a3 = a2 + kstep; const char* b3 = b2 + kstep;
            if constexpr (SP2) {
            PG8_LDB(B0, 0, 0); PG8_LDB(B1, 0, 1); PG8_SCHED; PG8_LDA(At, 0, 0); PG8_STAGE(PG8_SA(1, 1), a1 + hstep, voffA);
            PG8_WAIT_V(8); PG8_WAIT_L(0); PG8_BAR; PG8_MMA(0, 0, At, B0); PG8_MMA(0, 1, At, B1); PG8_BAR; PG8_SCHED;
            PG8_LDA(At, 0, 1); PG8_STAGE(PG8_SB(0, 0), b2, voffB); PG8_STAGE(PG8_SB(0, 1), b2 + hstep, voffB); PG8_STAGE(PG8_SA(0, 0), a2, voffA);
            PG8_WAIT_V(8); PG8_WAIT_L(0); PG8_BAR; PG8_MMA(1, 0, At, B0); PG8_MMA(1, 1, At, B1); PG8_BAR; PG8_SCHED;
            PG8_LDB(B0, 1, 0); PG8_LDB(B1, 1, 1); PG8_SCHED; PG8_LDA(At, 1, 0); PG8_STAGE(PG8_SA(0, 1), a2 + hstep, voffA);
            PG8_WAIT_V(8); PG8_WAIT_L(0); PG8_BAR; PG8_MMA(0, 0, At, B0); PG8_MMA(0, 1, At, B1); PG8_BAR; PG8_SCHED;
            PG8_LDA(At, 1, 1); PG8_STAGE(PG8_SB(1, 0), b3, voffB); PG8_STAGE(PG8_SB(1, 1), b3 + hstep, voffB); PG8_STAGE(PG8_SA(1, 0), a3, voffA);
            PG8_WAIT_V(8); PG8_WAIT_L(0); PG8_BAR; PG8_MMA(1, 0, At, B0); PG8_MMA(1, 1, At, B1); PG8_BAR; PG8_SCHED;
            } else {
            PG8_LDB(B0, 0, 0); PG8_SCHED; PG8_LDA(At, 0, 0); PG8_STAGE(PG8_SA(1, 1), a1 + hstep, voffA);
            PG8_WAIT_L(8); PG8_BAR; PG8_WAIT_L(0); PG8_MMA(0, 0, At, B0); PG8_BAR; PG8_SCHED;
            PG8_LDB(B1, 0, 1); PG8_STAGE(PG8_SB(0, 0), b2, voffB);
            PG8_BAR; PG8_WAIT_L(0); PG8_MMA(0, 1, At, B1); PG8_BAR;
            PG8_LDA(At, 0, 1); PG8_STAGE(PG8_SA(0, 0), a2, voffA);
            PG8_BAR; PG8_WAIT_L(0); PG8_MMA(1, 0, At, B0); PG8_BAR; PG8_SCHED;
            PG8_STAGE(PG8_SB(0, 1), b2 + hstep, voffB);
            PG8_WAIT_V(6); PG8_BAR; PG8_MMA(1, 1, At, B1); PG8_BAR;
            PG8_LDB(B0, 1, 0); PG8_SCHED; PG8_LDA(At, 1, 0); PG8_STAGE(PG8_SA(0, 1), a2 + hstep, voffA);
            PG8_WAIT_L(8); PG8_BAR; PG8_WAIT_L(0); PG8_MMA(0, 0, At, B0); PG8_BAR; PG8_SCHED;
            PG8_LDB(B1, 1, 1); PG8_STAGE(PG8_SB(1, 0), b3, voffB);
            PG8_BAR; PG8_WAIT_L(0); PG8_MMA(0, 1, At, B1); PG8_BAR;
            PG8_LDA(At, 1, 1); PG8_STAGE(PG8_SA(1, 0), a3, voffA);
            PG8_BAR; PG8_WAIT_L(0); PG8_MMA(1, 0, At, B0); PG8_BAR; PG8_SCHED;
            PG8_STAGE(PG8_SB(1, 1), b3 + hstep, voffB);
            PG8_WAIT_V(6); PG8_BAR; PG8_MMA(1, 1, At, B1); PG8_BAR;
            }
        }
        if constexpr (ALIGN_EPI) { if (wr == 0) PG8_BAR; }
        E(acc, cur, wr, wc, fr, fq);
        if (!has_next) break;
#pragma unroll
        for (int a = 0; a < 2; ++a)
#pragma unroll
            for (int b = 0; b < 2; ++b)
#pragma unroll
                for (int m = 0; m < 4; ++m)
#pragma unroll
                    for (int n = 0; n < 2; ++n) acc[a][b][m][n] = (f32x4){0.f, 0.f, 0.f, 0.f};
        cur = nxt; cA = nA; cB = nB; ++ui;
        if constexpr (ALIGN_EPI) { if (wr == 1) PG8_BAR; }
    }
    PG8_WAIT_V(0);
    if constexpr (!ALIGN_EPI) { if (wr == 0) PG8_BAR; }
    PG8_BAR;
#undef PG8_SA
#undef PG8_SB
#undef PG8_STAGE
#undef PG8_LDA
#undef PG8_LDB
#undef PG8_MMA
#undef PG8_WAIT_V
#undef PG8_WAIT_L
#undef PG8_BAR
#undef PG8_SCHED
}

struct EpiBf16 {
    static constexpr bool PERM = true;
    bf16_t* O; int ldc; const float* cs;
    __device__ __forceinline__ void operator()(const f32x4 (&acc)[2][2][4][2], const Unit& u, int wr, int wc, int fr, int fq) const {
        const int row0 = u.pm * BM + wr * 64 + fr; const int col0 = u.pn * BM + wc * 32 + 8 * fq;
        f32x4 rs[2][2];
#pragma unroll
        for (int bj = 0; bj < 2; ++bj)
#pragma unroll
            for (int n = 0; n < 2; ++n)
#pragma unroll
                for (int e = 0; e < 4; ++e) rs[bj][n][e] = __builtin_amdgcn_rsqf(row_ss(cs, col0 + bj * HALF + 4 * n + e) * (1.0f / DM) + EPS);
#pragma unroll
        for (int ai = 0; ai < 2; ++ai)
#pragma unroll
            for (int m = 0; m < 4; ++m) { bf16_t* rowp = O + (size_t)(row0 + ai * HALF + m * 16) * ldc + col0;
#pragma unroll
                for (int bj = 0; bj < 2; ++bj) { const f32x4 v0 = acc[ai][bj][m][0] * rs[bj][0], v1 = acc[ai][bj][m][1] * rs[bj][1];
                    u32x4 w; w.x = cvtpk(v0[0], v0[1]); w.y = cvtpk(v0[2], v0[3]); w.z = cvtpk(v1[0], v1[1]); w.w = cvtpk(v1[2], v1[3]);
                    *(u32x4*)(rowp + bj * HALF) = w; } }
    }
};
struct EpiSwiGLU {
    static constexpr bool PERM = true;
    bf16_t* O; int ldc; const float* sa; const float* sb;
    __device__ __forceinline__ void operator()(const f32x4 (&acc)[2][2][4][2], const Unit& u, int wr, int wc, int fr, int fq) const {
        const int row0 = u.pm * BM + wr * 64 + fr; const int col0 = u.pn * HALF + wc * 32 + 8 * fq;
#pragma unroll
        for (int ai = 0; ai < 2; ++ai)
#pragma unroll
            for (int m = 0; m < 4; ++m) { const int row = row0 + ai * HALF + m * 16; bf16_t* rowp = O + (size_t)row * ldc + col0;
                float rs = __builtin_amdgcn_rsqf(row_ss(sa, row) * (1.0f / DM) + EPS);
                if (sb) rs *= __builtin_amdgcn_rsqf(rs * rs * row_ss(sb, row) * (1.0f / DM) + EPS);
                float o[8];
#pragma unroll
                for (int n = 0; n < 2; ++n)
#pragma unroll
                    for (int e = 0; e < 4; ++e) { const float gt = acc[ai][0][m][n][e] * rs, up = acc[ai][1][m][n][e] * rs; o[n * 4 + e] = gt * fast_sigmoid(gt) * up; }
                u32x4 w; w.x = cvtpk(o[0], o[1]); w.y = cvtpk(o[2], o[3]); w.z = cvtpk(o[4], o[5]); w.w = cvtpk(o[6], o[7]);
                *(u32x4*)rowp = w; }
    }
};
struct EpiResid {
    static constexpr bool PERM = true;
    const float* src32; bf16_t* xb; float alpha; const float* srs; const float* scg; float* st1; float* st2; const float* cg2;
    __device__ __forceinline__ void operator()(const f32x4 (&acc)[2][2][4][2], const Unit& u, int wr, int wc, int fr, int fq) const {
        const int row0 = u.pm * BM + wr * 64 + fr; const int col0 = u.pn * BM + wc * 32 + 8 * fq;
#pragma unroll
        for (int ai = 0; ai < 2; ++ai)
#pragma unroll
            for (int m = 0; m < 4; ++m) { const int row = row0 + ai * HALF + m * 16; const size_t off = (size_t)row * DM + col0;
                const float rsrc = srs ? __builtin_amdgcn_rsqf(row_ss(srs, row) * (1.0f / DM) + EPS) : 1.0f;
                float p1 = 0.f, p2 = 0.f;
#pragma unroll
                for (int bj = 0; bj < 2; ++bj) { const int co = bj * HALF;
                    f32x4 s0, s1;
                    if (src32) { s0 = *(const f32x4*)(src32 + off + co); s1 = *(const f32x4*)(src32 + off + co + 4); }
                    else { const u32x4 w = *(const u32x4*)(xb + off + co);
                        s0 = (f32x4){__uint_as_float(w.x << 16), __uint_as_float(w.x & 0xffff0000u), __uint_as_float(w.y << 16), __uint_as_float(w.y & 0xffff0000u)};
                        s1 = (f32x4){__uint_as_float(w.z << 16), __uint_as_float(w.z & 0xffff0000u), __uint_as_float(w.w << 16), __uint_as_float(w.w & 0xffff0000u)}; }
                    if (srs) { s0 = s0 * rsrc * *(const f32x4*)(scg + col0 + co); s1 = s1 * rsrc * *(const f32x4*)(scg + col0 + co + 4); }
                    const f32x4 v0 = s0 + acc[ai][bj][m][0] * alpha, v1 = s1 + acc[ai][bj][m][1] * alpha;
                    u32x4 wo; wo.x = cvtpk(v0[0], v0[1]); wo.y = cvtpk(v0[2], v0[3]); wo.z = cvtpk(v1[0], v1[1]); wo.w = cvtpk(v1[2], v1[3]);
                    *(u32x4*)(xb + off + co) = wo;
                    p1 += ((v0[0] * v0[0] + v0[1] * v0[1]) + (v0[2] * v0[2] + v0[3] * v0[3])) + ((v1[0] * v1[0] + v1[1] * v1[1]) + (v1[2] * v1[2] + v1[3] * v1[3]));
                    if (st2) { const f32x4 g0 = v0 * *(const f32x4*)(cg2 + col0 + co), g1 = v1 * *(const f32x4*)(cg2 + col0 + co + 4);
                        p2 += ((g0[0] * g0[0] + g0[1] * g0[1]) + (g0[2] * g0[2] + g0[3] * g0[3])) + ((g1[0] * g1[0] + g1[1] * g1[1]) + (g1[2] * g1[2] + g1[3] * g1[3])); } }
                p1 += __shfl_xor(p1, 16); p1 += __shfl_xor(p1, 32);
                if (st2) { p2 += __shfl_xor(p2, 16); p2 += __shfl_xor(p2, 32); }
                if (fq == 0) { const int slot = u.pn * 4 + wc; st1[(size_t)row * 16 + slot] = p1; if (st2) st2[(size_t)row * 16 + slot] = p2; }
                asm volatile("" ::: "memory"); }
    }
};
struct EpiIn {
    static constexpr bool PERM = true;
    bf16_t *Z, *UP, *Q, *Kb; const float *qg, *kg; const float* sa;
    __device__ __forceinline__ void operator()(const f32x4 (&acc)[2][2][4][2], const Unit& u, int wr, int wc, int fr, int fq) const {
        const int row0 = u.pm * BM + wr * 64 + fr;
        if (u.pn < 2) {
            const int col0 = u.pn * HALF + wc * 32 + 8 * fq;
#pragma unroll
            for (int ai = 0; ai < 2; ++ai)
#pragma unroll
                for (int m = 0; m < 4; ++m) { const int row = row0 + ai * HALF + m * 16; bf16_t* rowp = Z + (size_t)row * 256 + col0;
                    const float rs = __builtin_amdgcn_rsqf(row_ss(sa, row) * (1.0f / DM) + EPS);
                    float o[8];
#pragma unroll
                    for (int n = 0; n < 2; ++n)
#pragma unroll
                        for (int e = 0; e < 4; ++e) o[n * 4 + e] = acc[ai][0][m][n][e] * rs * fast_sigmoid(acc[ai][1][m][n][e] * rs);
                    u32x4 w; w.x = cvtpk(o[0], o[1]); w.y = cvtpk(o[2], o[3]); w.z = cvtpk(o[4], o[5]); w.w = cvtpk(o[6], o[7]);
                    *(u32x4*)rowp = w; }
        } else if (u.pn == 2) {
            const int col0 = wc * 32 + 8 * fq;
#pragma unroll
            for (int ai = 0; ai < 2; ++ai)
#pragma unroll
                for (int m = 0; m < 4; ++m) { const int row = row0 + ai * HALF + m * 16; bf16_t* rowp = UP + (size_t)row * 256 + col0;
                    const float rs = __builtin_amdgcn_rsqf(row_ss(sa, row) * (1.0f / DM) + EPS);
#pragma unroll
                    for (int bj = 0; bj < 2; ++bj) { const f32x4 v0 = acc[ai][bj][m][0] * rs, v1 = acc[ai][bj][m][1] * rs;
                        u32x4 w; w.x = cvtpk(v0[0], v0[1]); w.y = cvtpk(v0[2], v0[3]); w.z = cvtpk(v1[0], v1[1]); w.w = cvtpk(v1[2], v1[3]);
                        *(u32x4*)(rowp + bj * HALF) = w; } }
        } else {
            const bool isq = u.pn < 5; const int T = (u.pn - 3) & 1;
            bf16_t* O = isq ? Q : Kb; const float* gp = isq ? qg : kg; const float sc = isq ? (0.125f * LOG2E) : 1.0f;
            const int col0 = 256 * T + 64 * wc + 8 * fq;
#pragma unroll
            for (int ai = 0; ai < 2; ++ai)
#pragma unroll
                for (int m = 0; m < 4; ++m) {
                    const int row = row0 + ai * HALF + m * 16;
                    const float r0 = __builtin_amdgcn_rsqf(row_ss(sa, row) * (1.0f / DM) + EPS);
                    float ss = 0.f;
#pragma unroll
                    for (int bj = 0; bj < 2; ++bj)
#pragma unroll
                        for (int n = 0; n < 2; ++n) { const f32x4 v = acc[ai][bj][m][n]; ss += (v[0] * v[0] + v[1] * v[1]) + (v[2] * v[2] + v[3] * v[3]); }
                    ss += __shfl_xor(ss, 16); ss += __shfl_xor(ss, 32);
                    const float rs = __builtin_amdgcn_rsqf(ss * r0 * r0 * (1.0f / 64.0f) + EPS) * r0 * sc;
                    bf16_t* rowp = O + (size_t)row * 512 + col0;
#pragma unroll
                    for (int bj = 0; bj < 2; ++bj) { const f32x4 g0 = *(const f32x4*)(gp + 32 * bj + 8 * fq), g1 = *(const f32x4*)(gp + 32 * bj + 8 * fq + 4);
                        const f32x4 v0 = acc[ai][bj][m][0] * rs * g0, v1 = acc[ai][bj][m][1] * rs * g1;
                        u32x4 w; w.x = cvtpk(v0[0], v0[1]); w.y = cvtpk(v0[2], v0[3]); w.z = cvtpk(v1[0], v1[1]); w.w = cvtpk(v1[2], v1[3]);
                        *(u32x4*)(rowp + bj * 32) = w; }
                    asm volatile("" ::: "memory"); }
        }
    }
};
}

constexpr size_t MiB = 1u << 20;
constexpr size_t WS_CTL = 0;
constexpr size_t WS_W = 2 * MiB, W_LAYER = 40 * MiB;
constexpr size_t WO_GU1 = 0, WO_D1 = 11 * MiB, WO_IN = WO_D1 + 5 * MiB + 512 * 1024, WO_OUT = WO_IN + 4 * MiB + 512 * 1024, WO_GU2 = WO_OUT + 2 * MiB, WO_D2 = WO_GU2 + 11 * MiB;
static_assert(WO_D2 + 5 * MiB + 512 * 1024 <= W_LAYER, "weights");
constexpr size_t WS_XN = 96 * MiB, WS_Y = 160 * MiB, WS_HID = 224 * MiB;
constexpr size_t WS_Z = WS_HID, WS_UP = WS_HID + 16 * MiB, WS_Q = WS_HID + 32 * MiB, WS_K = WS_HID + 64 * MiB, WS_VT = WS_HID + 96 * MiB;
constexpr size_t WS_END = WS_HID + 176 * MiB;
constexpr size_t WS_ST = WS_END;
constexpr size_t WS_TOTAL = WS_ST + 9 * (size_t)M * 16 * 4;
constexpr int LDS_BYTES = 131072 + 1024;

__device__ __forceinline__ void tr_item(const float* src, int pitch, bf16_t* dst, int K, int k0, LAS float* scr, int lane, const float* ga, const float* gb) {
    float wv[32];
#pragma unroll
    for (int i = 0; i < 32; ++i) wv[i] = src[(size_t)(k0 + 2 * i + (lane >> 5)) * pitch + (lane & 31)];
#pragma unroll
    for (int i = 0; i < 32; ++i) { const int kk = 2 * i + (lane >> 5); float gs = ga ? ga[k0 + kk] : 1.0f; if (gb) gs *= gb[k0 + kk];
        scr[kk * 33 + (lane & 31)] = wv[i] * gs; }
    asm volatile("s_waitcnt lgkmcnt(0)" ::: "memory");
    const int c = lane & 7;
#pragma unroll
    for (int j = 0; j < 4; ++j) { const int n = (lane >> 3) + 8 * j; const LAS float* s = scr + (8 * c) * 33 + n;
        u32x4 o; o.x = cvtpk(s[0 * 33], s[1 * 33]); o.y = cvtpk(s[2 * 33], s[3 * 33]); o.z = cvtpk(s[4 * 33], s[5 * 33]); o.w = cvtpk(s[6 * 33], s[7 * 33]);
        *(u32x4*)(dst + (size_t)n * K + k0 + 8 * c) = o; }
    asm volatile("s_waitcnt lgkmcnt(0)" ::: "memory");
}
__device__ __forceinline__ int in_colmap(int rho0) {
    if (rho0 < 512) { const int T = rho0 >> 8, bj = (rho0 >> 7) & 1, i0 = rho0 & 127; return bj * 256 + 128 * T + i0; }
    if (rho0 < 768 || rho0 >= 1792) return rho0;
    const int loc = rho0 - 768, T = loc >> 8, bj = (loc >> 7) & 1, wc = (loc >> 5) & 3;
    return 768 + 256 * T + 64 * wc + 32 * bj;
}

struct Args { const float* in[26]; float* out; unsigned char* ws; int ph_lo, ph_hi; };

__device__ __forceinline__ void attn_unit(LAS unsigned char* lds, const bf16_t* __restrict__ Qg, const bf16_t* __restrict__ Kg, const bf16_t* __restrict__ Vtg, bf16_t* Y,
                                          int b, int h, int qb, float slope2, float lam, const float* subln, int layer, int W, float wthr1) {
    int tid = threadIdx.x; asm volatile("" : "+v"(tid));
    const int lane = tid & 63, wid = __builtin_amdgcn_readfirstlane(tid >> 6), c = wid >> 2, qw = wid & 3, r32 = lane & 31, hi = lane >> 5;
    const int q0 = qb * 128, qpos = q0 + 32 * qw + r32;
    const size_t rowbase = (size_t)b * SEQ;
    bf16x8 qf[4];
    { const bf16_t* qp = Qg + (rowbase + qpos) * 512 + h * 128 + c * 64 + hi * 8;
#pragma unroll
      for (int d0 = 0; d0 < 4; ++d0) qf[d0] = *(const bf16x8*)(qp + 16 * d0);
      asm volatile("s_waitcnt vmcnt(0)" ::: "memory");
#pragma unroll
      for (int d0 = 0; d0 < 4; ++d0) asm volatile("" : "+v"(qf[d0])); }
    int jlo = q0 - W; if (jlo < 0) jlo = 0; jlo &= ~63;
    int jhi = (q0 + 128 + W + 63) & ~63; if (jhi > SEQ) jhi = SEQ;
    const int nT = (jhi - jlo) >> 6;
    const int srow = lane >> 3;
    const int krow_s = 8 * wid + srow, kch_s = (lane & 7) ^ ((krow_s >> 1) & 7);
    const bf16_t* kgp = Kg + (rowbase + krow_s) * 512 + h * 128 + kch_s * 8;
    const int vrow_s = 8 * wid + srow, vch_s = (lane & 7) ^ ((vrow_s >> 1) & 7);
    const bf16_t* vgp = Vtg + (size_t)(h * 128 + vrow_s) * VT_PITCH + rowbase + vch_s * 8;
    const int pi = (r32 & ~12) | ((r32 & 4) << 1) | ((r32 & 8) >> 1);
    const int swk = (pi >> 1) & 7, swv = (r32 >> 1) & 7;
    const int kbase = c * 8192 + pi * 128, vbase = r32 * 128;
    const int kc0 = (hi ^ swk) << 4, vc0 = (hi ^ swv) << 4;

    f32x16 o[4];
#pragma unroll
    for (int i = 0; i < 4; ++i)
#pragma unroll
        for (int r = 0; r < 16; ++r) o[i][r] = 0.f;
    float lsum = 0.f;
#define ATT_DMA(T_, SLOT_) do { const int sl_ = (SLOT_) * 16384; const bf16_t* kp_ = kgp + (size_t)(T_) * 64 * 512; const bf16_t* vp_ = vgp + (T_) * 64; \
        __builtin_amdgcn_global_load_lds((const unsigned*)kp_, (LAS unsigned*)(lds + sl_ + wid * 1024), 16, 0, 0); \
        __builtin_amdgcn_global_load_lds((const unsigned*)(kp_ + 64), (LAS unsigned*)(lds + sl_ + 8192 + wid * 1024), 16, 0, 0); \
        __builtin_amdgcn_global_load_lds((const unsigned*)vp_, (LAS unsigned*)(lds + 65536 + sl_ + wid * 1024), 16, 0, 0); \
        __builtin_amdgcn_global_load_lds((const unsigned*)(vp_ + (size_t)64 * VT_PITCH), (LAS unsigned*)(lds + 65536 + sl_ + 8192 + wid * 1024), 16, 0, 0); } while (0)
#define SB() __builtin_amdgcn_sched_barrier(0)
#define ATT_SOFTMAX(S_, FB_, PA_, PB_) do { \
        _Pragma("unroll") for (int r = 0; r < 16; ++r) { const float tt = (FB_) + (float)(16 * (r >> 3) + (r & 7)); const float p = __builtin_amdgcn_exp2f(__builtin_fmaf(-slope2, __builtin_fabsf(tt), S_[r])); lsum += p; S_[r] = p; } \
        u32x4 w0_, w1_; \
        w0_.x = cvtpk(S_[0], S_[1]); w0_.y = cvtpk(S_[2], S_[3]); w0_.z = cvtpk(S_[4], S_[5]); w0_.w = cvtpk(S_[6], S_[7]); \
        w1_.x = cvtpk(S_[8], S_[9]); w1_.y = cvtpk(S_[10], S_[11]); w1_.z = cvtpk(S_[12], S_[13]); w1_.w = cvtpk(S_[14], S_[15]); \
        PA_ = __builtin_bit_cast(bf16x8, w0_); PB_ = __builtin_bit_cast(bf16x8, w1_); } while (0)
#define ATT_RDV(VF_, VB_, S4_) do { _Pragma("unroll") for (int db = 0; db < 4; ++db) VF_[db] = *(const LAS bf16x8*)((VB_) + db * 4096 + (vc0 ^ ((S4_) * 32))); } while (0)
#define ATT_PV(PA_, VF_) do { _Pragma("unroll") for (int db = 0; db < 4; ++db) o[db] = __builtin_amdgcn_mfma_f32_32x32x16_bf16(PA_, VF_[db], o[db], 0, 0, 0); } while (0)
    const float sl_lane = hi ? 0.0f : slope2;
    const float cl_lane = (float)(pi - 32 * qw);
    bf16x8 qaug;
    { u32x4 w_; w_.x = 0x3f803f80u; w_.y = cvtpk((float)r32, (float)r32); w_.z = 0u; w_.w = 0u; qaug = __builtin_bit_cast(bf16x8, w_); }
#define ATT_SPLIT(V_) cvtpk((V_), (V_) - __uint_as_float(cvtpk((V_), 0.0f) << 16))
#define ATT_STEP(MODE_) do { \
        const float fb0 = (float)(j0 + 8 * hi - qpos), fb1 = fb0 + 32.0f; \
        const LAS unsigned char* kb_ = lds + sl + kbase; const LAS unsigned char* vb_ = lds + 65536 + sl + vbase; \
        bf16x8 kf[4], kg[4], vf0[4], vf1[4], pa0, pa1, pa2, pa3; \
        f32x16 s0, s1; \
        SB(); \
        _Pragma("unroll") for (int d0 = 0; d0 < 4; ++d0) { kf[d0] = *(const LAS bf16x8*)(kb_ + (kc0 ^ (d0 * 32))); kg[d0] = *(const LAS bf16x8*)(kb_ + 4096 + (kc0 ^ (d0 * 32))); } \
        SB(); \
        _Pragma("unroll") for (int r = 0; r < 16; ++r) { s0[r] = 0.f; s1[r] = 0.f; } \
        if ((MODE_) != 0) { \
            const float v0_ = -(float)(MODE_) * sl_lane * ((float)(j0 - q0) + cl_lane), v1_ = v0_ - (float)(MODE_) * sl_lane * 32.0f; \
            const float sg_ = (float)(MODE_) * sl_lane; \
            u32x4 a0_, a1_; a0_.x = ATT_SPLIT(v0_); a1_.x = ATT_SPLIT(v1_); a0_.y = ATT_SPLIT(sg_); a1_.y = a0_.y; a0_.z = 0u; a0_.w = 0u; a1_.z = 0u; a1_.w = 0u; \
            s0 = __builtin_amdgcn_mfma_f32_32x32x16_bf16(__builtin_bit_cast(bf16x8, a0_), qaug, s0, 0, 0, 0); \
            s1 = __builtin_amdgcn_mfma_f32_32x32x16_bf16(__builtin_bit_cast(bf16x8, a1_), qaug, s1, 0, 0, 0); } \
        _Pragma("unroll") for (int d0 = 0; d0 < 4; ++d0) s0 = __builtin_amdgcn_mfma_f32_32x32x16_bf16(kf[d0], qf[d0], s0, 0, 0, 0); \
        _Pragma("unroll") for (int d0 = 0; d0 < 4; ++d0) s1 = __builtin_amdgcn_mfma_f32_32x32x16_bf16(kg[d0], qf[d0], s1, 0, 0, 0); \
        ATT_RDV(vf0, vb_, 0); \
        if ((MODE_) != 0) ATT_SOFTMAX_LIN(s0, pa0, pa1); else ATT_SOFTMAX(s0, fb0, pa0, pa1); \
        __builtin_amdgcn_sched_group_barrier(0x008, ((MODE_) != 0) ? 10 : 8, 0);        \
        __builtin_amdgcn_sched_group_barrier(0x100, 4, 0);                                \
        __builtin_amdgcn_sched_group_barrier(0x002, 80, 0);                               \
        SB(); \
        ATT_RDV(vf1, vb_, 1); ATT_PV(pa0, vf0); \
        SB(); \
        ATT_RDV(vf0, vb_, 2); ATT_PV(pa1, vf1); \
        SB(); \
        if ((MODE_) != 0) ATT_SOFTMAX_LIN(s1, pa2, pa3); else ATT_SOFTMAX(s1, fb1, pa2, pa3); \
        SB(); \
        ATT_RDV(vf1, vb_, 3); ATT_PV(pa2, vf0); \
        SB(); \
        ATT_PV(pa3, vf1); \
        SB(); } while (0)
#define ATT_SOFTMAX_LIN(S_, PA_, PB_) do { \
        _Pragma("unroll") for (int r = 0; r < 16; ++r) { const float p = __builtin_amdgcn_exp2f(S_[r]); lsum += p; S_[r] = p; } \
        u32x4 w0_, w1_; \
        w0_.x = cvtpk(S_[0], S_[1]); w0_.y = cvtpk(S_[2], S_[3]); w0_.z = cvtpk(S_[4], S_[5]); w0_.w = cvtpk(S_[6], S_[7]); \
        w1_.x = cvtpk(S_[8], S_[9]); w1_.y = cvtpk(S_[10], S_[11]); w1_.z = cvtpk(S_[12], S_[13]); w1_.w = cvtpk(S_[14], S_[15]); \
        PA_ = __builtin_bit_cast(bf16x8, w0_); PB_ = __builtin_bit_cast(bf16x8, w1_); } while (0)
    const int Tm0 = q0 >> 6;
    int Tlo = jlo >> 6, Thi = (jhi >> 6) - 1;
    int kl = 1, kr = 1, side = 0, phase2 = 0, swl = 0, swr = 0, swlu = -1;
#define ATT_GEN(OUT_) do { int o_ = -1; \
        if (phase2) { if (swl <= swlu) o_ = swl++; else if (swr <= Thi) o_ = swr++; } \
        else { const int lt_ = Tm0 - kl, rt_ = Tm0 + 1 + kr; const bool lok_ = lt_ >= Tlo, rok_ = rt_ <= Thi; \
            if (lok_ && (side == 0 || !rok_)) { o_ = lt_; ++kl; side = 1; } else if (rok_) { o_ = rt_; ++kr; side = 0; } } \
        OUT_ = o_; } while (0)
    int tq0 = Tm0, tq1 = Tm0 + 1, tq2, tq3;
    ATT_GEN(tq2); ATT_GEN(tq3);
    ATT_DMA(tq0, 0); ATT_DMA(tq1, 1); ATT_DMA((tq2 < 0 ? Tm0 : tq2), 2);
    const int kcp = (int)(1.5f / (slope2 * 64.0f)) + 1, ic = 2 + 2 * kcp;
    for (int i = 0; tq0 >= 0; ++i) {
        asm volatile("s_waitcnt vmcnt(8)" ::: "memory");
        __builtin_amdgcn_s_barrier();
        asm volatile("" ::: "memory");
        ATT_DMA((tq3 < 0 ? Tm0 : tq3), (i + 3) & 3);
        const int sl = (i & 3) * 16384;
        const int j0 = tq0 << 6;
        if (tq0 < Tm0) ATT_STEP(-1); else if (tq0 > Tm0 + 1) ATT_STEP(1); else ATT_STEP(0);
        tq0 = tq1; tq1 = tq2; tq2 = tq3; ATT_GEN(tq3);
        if (i + 1 == ic && tq0 >= 0) {
            float lr = lsum + __shfl_xor(lsum, 32);
#pragma unroll
            for (int m = 1; m < 32; m <<= 1) lr = __builtin_fminf(lr, __shfl_xor(lr, m));
            volatile LAS float* red = (volatile LAS float*)(lds + 131072 + 64);
            if (lane == 0) red[wid] = lr;
            asm volatile("s_waitcnt lgkmcnt(0)" ::: "memory"); __builtin_amdgcn_s_barrier(); asm volatile("" ::: "memory");
            float lm = red[0];
#pragma unroll
            for (int w8 = 1; w8 < 8; ++w8) lm = __builtin_fminf(lm, red[w8]);
            lm = __builtin_bit_cast(float, __builtin_amdgcn_readfirstlane(__builtin_bit_cast(int, lm)));
            const float wn = (wthr1 - __builtin_amdgcn_logf(lm)) / slope2 + 1.0f;
            if (wn < (float)W) { const int Wn = wn > 0.f ? (int)wn : 0;
                int jl2 = q0 - Wn; if (jl2 < 0) jl2 = 0; jl2 &= ~63; int jh2 = (q0 + 128 + Wn + 63) & ~63; if (jh2 > SEQ) jh2 = SEQ;
                if ((jl2 >> 6) > Tlo) Tlo = jl2 >> 6; if ((jh2 >> 6) - 1 < Thi) Thi = (jh2 >> 6) - 1; }
            phase2 = 1; swl = Tlo; swlu = Tm0 - kl; swr = Tm0 + 1 + kr;
        }
    }
    asm volatile("s_waitcnt vmcnt(0)" ::: "memory");
    __syncthreads();
#undef ATT_DMA
#undef ATT_GEN
#undef ATT_SOFTMAX
#undef ATT_SOFTMAX_LIN
#undef ATT_STEP
#undef ATT_SPLIT
#undef ATT_RDV
#undef ATT_PV
#undef SB
    lsum += __shfl_xor(lsum, 32);
    const float inv = 1.0f / lsum;
    float invr[16];
#pragma unroll
    for (int r = 0; r < 16; ++r) invr[r] = __shfl(inv, (r & 3) + 8 * (r >> 2) + 4 * hi);
    LAS float* X = (LAS float*)lds + qw * 4096;
    if (c == 1) {
#pragma unroll
        for (int db = 0; db < 4; ++db)
#pragma unroll
            for (int r = 0; r < 16; ++r) X[((r & 3) + 8 * (r >> 2) + 4 * hi) * 128 + 32 * db + r32] = o[db][r] * invr[r] * lam;
    }
    __syncthreads();
    if (c == 0) {
        float ss[16];
#pragma unroll
        for (int r = 0; r < 16; ++r) ss[r] = 0.f;
#pragma unroll
        for (int db = 0; db < 4; ++db)
#pragma unroll
            for (int r = 0; r < 16; ++r) { const float v = o[db][r] * invr[r] - X[((r & 3) + 8 * (r >> 2) + 4 * hi) * 128 + 32 * db + r32]; o[db][r] = v; ss[r] += v * v; }
#pragma unroll
        for (int r = 0; r < 16; ++r) {
#pragma unroll
            for (int m = 1; m < 32; m <<= 1) ss[r] += __shfl_xor(ss[r], m);
            ss[r] = __builtin_amdgcn_rsqf(ss[r] * (1.0f / 128.0f) + EPS) * (layer == 0 ? 0.8f : 0.64449093f);
        }
        asm volatile("s_waitcnt lgkmcnt(0)" ::: "memory");
        LAS bf16_t* Sg = (LAS bf16_t*)(lds + qw * 16384);
#pragma unroll
        for (int db = 0; db < 4; ++db) { const float g = subln[32 * db + r32];
#pragma unroll
            for (int r = 0; r < 16; ++r) { const unsigned pk = cvtpk(o[db][r] * ss[r] * g, 0.f); Sg[((r & 3) + 8 * (r >> 2) + 4 * hi) * 128 + 32 * db + r32] = (bf16_t)(pk & 0xffffu); } }
        asm volatile("s_waitcnt lgkmcnt(0)" ::: "memory");
        bf16_t* yb = Y + (rowbase + q0 + 32 * qw) * 1024 + 512 + h * 128;
#pragma unroll
        for (int i = 0; i < 8; ++i) { const int ch = lane + 64 * i, row = ch >> 4, cc = ch & 15; const u32x4 v = *(const LAS u32x4*)((LAS unsigned char*)Sg + row * 256 + cc * 16); *(u32x4*)(yb + (size_t)row * 1024 + cc * 8) = v; }
    }
    __syncthreads();
}

__device__ __forceinline__ void conv_unit(LAS unsigned char* lds, const bf16_t* __restrict__ Z, bf16_t* Y, int b, int t0, const float* wdw, const float* bdw, const float* lng, const float* lnb) {
    int tid = threadIdx.x; asm volatile("" : "+v"(tid));
    const int lane = tid & 63, wid = tid >> 6, c = tid & 255, half = tid >> 8;
    float w[31];
#pragma unroll
    for (int j = 0; j < 31; ++j) w[j] = wdw[j * 256 + c];
    float acc[32]; const float bias = bdw[c];
#pragma unroll
    for (int o = 0; o < 32; ++o) acc[o] = bias;
    const int tf = t0 + 32 * half - 15;
    const bf16_t* zb = Z + ((size_t)b * SEQ) * 256 + c;
#pragma unroll
    for (int i = 0; i < 62; ++i) {
        const int row = tf + i; const float z = (row >= 0 && row < SEQ) ? bf2f(zb[(size_t)row * 256]) : 0.f;
#pragma unroll
        for (int o = 0; o < 32; ++o) { const int j = i - o; if (j >= 0 && j <= 30) acc[o] = __builtin_fmaf(w[j], z, acc[o]); }
    }
    LAS float* T = (LAS float*)lds;
#pragma unroll
    for (int o = 0; o < 32; ++o) T[(32 * half + o) * 256 + c] = acc[o];
    __syncthreads();
    const f32x4 g4 = ((const f32x4*)lng)[lane], b4 = ((const f32x4*)lnb)[lane];
#pragma unroll
    for (int k = 0; k < 8; ++k) {
        const int tok = wid * 8 + k;
        const f32x4 v = *(const LAS f32x4*)(T + tok * 256 + 4 * lane);
        const float mean = wave_sum((v.x + v.y) + (v.z + v.w)) * (1.f / 256.f);
        const f32x4 d = v - mean;
        const float var = wave_sum((d.x * d.x + d.y * d.y) + (d.z * d.z + d.w * d.w)) * (1.f / 256.f);
        const float rs = __builtin_amdgcn_rsqf(var + EPS);
        f32x4 y = d * rs * g4 + b4;
        y.x *= fast_sigmoid(y.x); y.y *= fast_sigmoid(y.y); y.z *= fast_sigmoid(y.z); y.w *= fast_sigmoid(y.w);
        u32x2 wv; wv.x = cvtpk(y.x, y.y); wv.y = cvtpk(y.z, y.w);
        *(u32x2*)(Y + ((size_t)b * SEQ + t0 + tok) * 1024 + 4 * lane) = wv;
    }
    __syncthreads();
}

constexpr int POOL_TP = 260;
template <int HW> __device__ __forceinline__ void pool_diff(const bf16_t* __restrict__ ub, int tfirst, LAS float* T, int half, int c) {
    float r[47];
#pragma unroll
    for (int i = 0; i < 47; ++i) { const int row = tfirst - 8 + i; r[i] = (row >= 0 && row < SEQ && i >= 8 - HW && i < 8 + 32 + HW - 1) ? bf2f(ub[(size_t)row * 256]) : 0.f; }
#pragma unroll
    for (int o = 0; o < 32; ++o) {
        float s = 0.f;
#pragma unroll
        for (int k = -HW; k < HW; ++k) s += r[8 + o + k];
        const int t = tfirst + o; int lo = t - HW; if (lo < 0) lo = 0; int hi = t + HW; if (hi > SEQ) hi = SEQ;
        T[(32 * half + o) * POOL_TP + c] = s / (float)(hi - lo) - r[8 + o];
    }
}
__device__ __forceinline__ void pool_unit(LAS unsigned char* lds, const bf16_t* __restrict__ UP, bf16_t* Y, int b, int t0, const float* pw, const float* pscale) {
    int tid = threadIdx.x; asm volatile("" : "+v"(tid));
    LAS float* T = (LAS float*)lds;
    { const int c = tid & 255, half = tid >> 8, g = __builtin_amdgcn_readfirstlane(c >> 6);
      const bf16_t* ub = UP + ((size_t)b * SEQ) * 256 + c;
      const int tfirst = t0 + 32 * half;
      if (g == 0) pool_diff<1>(ub, tfirst, T, half, c);
      else if (g == 1) pool_diff<2>(ub, tfirst, T, half, c);
      else if (g == 2) pool_diff<4>(ub, tfirst, T, half, c);
      else pool_diff<8>(ub, tfirst, T, half, c); }
    const int lane = tid & 63, wid = __builtin_amdgcn_readfirstlane(tid >> 6), g = wid & 3, half = wid >> 2, r32 = lane & 31, hi = lane >> 5;
    bf16x8 bw[4][2];
#pragma unroll
    for (int ks = 0; ks < 4; ++ks)
#pragma unroll
        for (int nb = 0; nb < 2; ++nb) { const float* wp = pw + (size_t)(g * 64 + 16 * ks + 8 * hi) * 64 + 32 * nb + r32;
            u32x4 w; w.x = cvtpk(wp[0], wp[64]); w.y = cvtpk(wp[128], wp[192]); w.z = cvtpk(wp[256], wp[320]); w.w = cvtpk(wp[384], wp[448]);
            bw[ks][nb] = __builtin_bit_cast(bf16x8, w); }
    __syncthreads();
    f32x16 acc0, acc1;
#pragma unroll
    for (int r = 0; r < 16; ++r) { acc0[r] = 0.f; acc1[r] = 0.f; }
#pragma unroll
    for (int ks = 0; ks < 4; ++ks) {
        const LAS f32x4* dp = (const LAS f32x4*)(T + (32 * half + r32) * POOL_TP + 64 * g + 16 * ks + 8 * hi);
        const f32x4 d0 = dp[0], d1 = dp[1];
        u32x4 w; w.x = cvtpk(d0[0], d0[1]); w.y = cvtpk(d0[2], d0[3]); w.z = cvtpk(d1[0], d1[1]); w.w = cvtpk(d1[2], d1[3]);
        const bf16x8 af = __builtin_bit_cast(bf16x8, w);
        acc0 = __builtin_amdgcn_mfma_f32_32x32x16_bf16(af, bw[ks][0], acc0, 0, 0, 0);
        acc1 = __builtin_amdgcn_mfma_f32_32x32x16_bf16(af, bw[ks][1], acc1, 0, 0, 0);
    }
    const float sc0 = pscale[64 * g + r32], sc1 = pscale[64 * g + 32 + r32];
    bf16_t* yb = Y + ((size_t)b * SEQ + t0 + 32 * half) * 1024 + 256 + 64 * g + r32;
#pragma unroll
    for (int r = 0; r < 16; ++r) { const int tok = (r & 3) + 8 * (r >> 2) + 4 * hi;
        yb[(size_t)tok * 1024] = (bf16_t)(cvtpk(acc0[r] * sc0, 0.f) & 0xffffu);
        yb[(size_t)tok * 1024 + 32] = (bf16_t)(cvtpk(acc1[r] * sc1, 0.f) & 0xffffu); }
    __syncthreads();
}

#define XB_TMO      128
#define XB_XCNT(j)  (256  + 64 * (j))
#define XB_XSUB(j)  (1280 + 64 * (j))
#define XB_XGEN(j)  (2304 + 64 * (j))
#define XB_TOP      3328
#define XB_TOPGEN   3392
#define XCD_BAR_WORDS 3456
#define XB_SPIN_CAP (1u << 18)
__device__ __forceinline__ unsigned xb_ld(unsigned* p)              { return __hip_atomic_load(p, __ATOMIC_RELAXED, __HIP_MEMORY_SCOPE_AGENT); }
__device__ __forceinline__ unsigned xb_add(unsigned* p, unsigned v) { return __hip_atomic_fetch_add(p, v, __ATOMIC_RELAXED, __HIP_MEMORY_SCOPE_AGENT); }
__device__ __forceinline__ unsigned xb_xcc_id() { return (unsigned)__builtin_amdgcn_s_getreg((3 << 11) | 20) & 0xFu; }
#define XB_SPIN(cond, bar) do { unsigned _sp = 0; while (cond) { __builtin_amdgcn_s_sleep(1); \
    if ((++_sp & 255u) == 0u) { if (xb_ld(&(bar)[XB_TMO])) break; if (_sp > XB_SPIN_CAP) { atomicAdd(&(bar)[XB_TMO], 1u); break; } } } } while (0)
struct XcdBarrier { unsigned* bar; unsigned x; volatile LAS unsigned* st; };
__device__ __forceinline__ XcdBarrier xcd_barrier_post(unsigned* bar, volatile LAS unsigned* st) {
    XcdBarrier b; b.bar = bar; b.x = xb_xcc_id(); b.st = st;
    if (threadIdx.x == 0) (void)xb_add(&bar[XB_XCNT(b.x)], 1u);
    return b;
}
__device__ __forceinline__ void xcd_barrier_complete(unsigned* bar, unsigned x, unsigned& nloc, unsigned& nx) {
    const unsigned G = gridDim.x * gridDim.y * gridDim.z;
    unsigned sum, cnt, mine, sp = 0u;
    for (;;) {
        sum = 0u; cnt = 0u; mine = 0u;
#pragma unroll
        for (unsigned j = 0; j < 16; ++j) { const unsigned c = xb_ld(&bar[XB_XCNT(j)]); sum += c; cnt += (c > 0u) ? 1u : 0u; mine = (j == x) ? c : mine; }
        if (sum == G) break;
        __builtin_amdgcn_s_sleep(1);
        if ((++sp & 255u) == 0u) { if (xb_ld(&bar[XB_TMO])) break; if (sp > XB_SPIN_CAP) { atomicAdd(&bar[XB_TMO], 1u); break; } }
    }
    nloc = mine > 0u ? mine : 1u; nx = cnt > 0u ? cnt : 1u;
}
__device__ __forceinline__ void xcd_barrier(const XcdBarrier& b) {
    asm volatile("s_waitcnt vmcnt(0)" ::: "memory");
    __syncthreads();
    if (threadIdx.x == 0) {
        unsigned* bar = b.bar; unsigned bx = b.x; asm volatile("" : "+s"(bar), "+s"(bx));
        __builtin_amdgcn_s_waitcnt(0);
        unsigned nloc = b.st[0], nx = b.st[1];
        if (nloc == 0u) { xcd_barrier_complete(bar, bx, nloc, nx); b.st[0] = nloc; b.st[1] = nx; }
        const unsigned old = xb_add(&bar[XB_XSUB(bx)], 1u);
        const unsigned gen = old / nloc;
        if (old + 1u == (gen + 1u) * nloc) {
            __builtin_amdgcn_fence(__ATOMIC_RELEASE, "agent");
            asm volatile("s_waitcnt vmcnt(0)" ::: "memory");
            const unsigned og = xb_add(&bar[XB_TOP], 1u);
            const unsigned tg = og / nx;
            if (og + 1u == (tg + 1u) * nx) xb_add(&bar[XB_TOPGEN], 1u);
            else XB_SPIN(xb_ld(&bar[XB_TOPGEN]) == tg, bar);
            __builtin_amdgcn_fence(__ATOMIC_ACQUIRE, "agent");
            xb_add(&bar[XB_XGEN(bx)], 1u);
            asm volatile("s_waitcnt vmcnt(0)" ::: "memory");
        } else {
            XB_SPIN(xb_ld(&bar[XB_XGEN(bx)]) == gen, bar);
            __builtin_amdgcn_fence(__ATOMIC_ACQUIRE, "agent");
            asm volatile("s_waitcnt vmcnt(0)" ::: "memory");
        }
    }
    __syncthreads();
}

constexpr int N_ATT_UNITS = NHEAD * NB * (SEQ / 128), N_CONV_UNITS = M / 64, N_POOL_UNITS = M / 64, N_MIX_UNITS = N_ATT_UNITS + N_CONV_UNITS + N_POOL_UNITS;
constexpr int NPHASE = 2 + 7 * NLAYER;

__global__ void __launch_bounds__(512, 2) fwd_kernel(Args args) {
    extern __shared__ __attribute__((aligned(16))) unsigned char lds_raw[];
    LAS unsigned char* lds = (LAS unsigned char*)lds_raw;
    volatile LAS int* misc = (volatile LAS int*)(lds + 131072);
    const int tid = threadIdx.x, lane = tid & 63, wave = __builtin_amdgcn_readfirstlane(tid >> 6);
    const int G = gridDim.x, gw = blockIdx.x * 8 + wave, NGW = G * 8;
    unsigned char* ws = args.ws;
    unsigned* ctl = (unsigned*)(ws + WS_CTL);
    bf16_t* XN = (bf16_t*)(ws + WS_XN); bf16_t* Yb = (bf16_t*)(ws + WS_Y); bf16_t* HID = (bf16_t*)(ws + WS_HID);
    bf16_t* Zb = (bf16_t*)(ws + WS_Z); bf16_t* UPb = (bf16_t*)(ws + WS_UP); bf16_t* Qb = (bf16_t*)(ws + WS_Q); bf16_t* Kb = (bf16_t*)(ws + WS_K); bf16_t* Vt = (bf16_t*)(ws + WS_VT);
    float* X = args.out;
#if MK_SINGLE
#define IN_PH(k) true
#else
    const int lo = args.ph_lo, hi = args.ph_hi;
#define IN_PH(k) (lo <= (k) && (k) < hi)
#endif
#if MK_SINGLE
    if (tid < 16) misc[tid] = 0;
    if (blockIdx.x == 0) for (int i = tid; i < 8192; i += 512) __hip_atomic_store(ctl + i, 0u, __ATOMIC_RELAXED, __HIP_MEMORY_SCOPE_AGENT);
    __threadfence(); cg::this_grid().sync();
    XcdBarrier gbar = xcd_barrier_post(ctl + 1024, (volatile LAS unsigned*)(misc + 8));
#define SEAM(k) do { if (IN_PH(k) && IN_PH((k) + 1)) xcd_barrier(gbar); } while (0)
#else
    if (lo == 0 && blockIdx.x == 0 && tid < 64) ctl[tid] = 0u;
#define SEAM(k) do { } while (0)
#endif

    float* ST = (float*)(ws + WS_ST);
    if (IN_PH(0)) {
        LAS float* scr = (LAS float*)(lds + wave * 16384);
        constexpr int I_GU = 16 * 176, I_D = 44 * 32, I_IN = 16 * 72, I_OUT = 16 * 32, I_LAYER = 2 * I_GU + 2 * I_D + I_IN + I_OUT;
        for (int it = gw; it < NLAYER * I_LAYER; it += NGW) {
            const int l = it / I_LAYER; int r = it % I_LAYER;
            unsigned char* wl = ws + WS_W + (size_t)l * W_LAYER;
            if (r < 2 * I_GU) {
                const int second = r >= I_GU; if (second) r -= I_GU;
                const int kb = r / 176, nb = r % 176, rho0 = 32 * nb, T = rho0 >> 8, bj = (rho0 >> 7) & 1, i0 = rho0 & 127;
                const float* src = args.in[second ? (bj ? 23 : 22) : (bj ? 3 : 2)] + (size_t)l * DM * DFF + 128 * T + i0;
                const float* ga = args.in[second ? 21 : 1] + l * DM;
                const float* gb = (!second && l > 0) ? args.in[25] + (l - 1) * DM : nullptr;
                tr_item(src, DFF, (bf16_t*)(wl + (second ? WO_GU2 : WO_GU1)) + (size_t)rho0 * DM, DM, 64 * kb, scr, lane, ga, gb);
                continue;
            }
            r -= 2 * I_GU;
            if (r < 2 * I_D) {
                const int second = r >= I_D; if (second) r -= I_D;
                const int kb = r / 32, nb = r % 32, rho0 = 32 * nb;
                const float* src = args.in[second ? 24 : 4] + (size_t)l * DFF * DM + rho0;
                tr_item(src, DM, (bf16_t*)(wl + (second ? WO_D2 : WO_D1)) + (size_t)rho0 * DFF, DFF, 64 * kb, scr, lane, nullptr, nullptr);
                continue;
            }
            r -= 2 * I_D;
            if (r < I_IN) {
                const int kb = r / 72, nb = r % 72, rho0 = 32 * nb;
                const float* src = args.in[6] + (size_t)l * DM * DIN + in_colmap(rho0);
                tr_item(src, DIN, (bf16_t*)(wl + WO_IN) + (size_t)rho0 * DM, DM, 64 * kb, scr, lane, args.in[5] + l * DM, nullptr);
                continue;
            }
            r -= I_IN;
            { const int kb = r / 32, nb = r % 32, rho0 = 32 * nb;
              const float* src = args.in[20] + (size_t)l * DM * DM + rho0;
              tr_item(src, DM, (bf16_t*)(wl + WO_OUT) + (size_t)rho0 * DM, DM, 64 * kb, scr, lane, nullptr, nullptr); }
        }
        for (int m = gw; m < M; m += NGW) {
            int ln = lane; asm volatile("" : "+v"(ln));
            const f32x4* xr = (const f32x4*)(args.in[0] + (size_t)m * DM) + ln; u32x2* o8 = (u32x2*)(XN + (size_t)m * DM) + ln;
            float sq = 0.f;
#pragma unroll
            for (int j = 0; j < 4; ++j) { const f32x4 v = xr[64 * j]; sq += (v.x * v.x + v.y * v.y) + (v.z * v.z + v.w * v.w); u32x2 w; w.x = cvtpk(v.x, v.y); w.y = cvtpk(v.z, v.w); o8[64 * j] = w; }
            sq = wave_sum(sq);
            if (ln < 16) ST[(size_t)m * 16 + ln] = (ln == 0) ? sq : 0.f;
        }
    }
    SEAM(0);

    for (int l = 0; l < NLAYER; ++l) {
        const int pb = 1 + 7 * l;
        unsigned char* wl = ws + WS_W + (size_t)l * W_LAYER;
        const float lambda_init = (l == 0) ? 0.2f : 0.35550907f;
        float* st_mix = ST + (size_t)(1 + 4 * l) * M * 16; float* st_ffn2 = ST + (size_t)(2 + 4 * l) * M * 16; float* st_post = ST + (size_t)(3 + 4 * l) * M * 16; float* st_post2 = ST + (size_t)(4 + 4 * l) * M * 16;
        const float* st_prev = (l == 0) ? ST : ST + (size_t)(3 + 4 * (l - 1)) * M * 16;
        const float* st_prev2 = (l == 0) ? nullptr : ST + (size_t)(4 + 4 * (l - 1)) * M * 16;
        if (IN_PH(pb + 0)) {
            pg8::Gemm g{XN, (const bf16_t*)(wl + WO_GU1), M, 2 * DFF, DM}; pg8::StaticOrder S; S.init(M, 2 * DFF, G, (int)blockIdx.x);
            pg8::EpiSwiGLU E{HID, DFF, st_prev, st_prev2};
            pg8::gemm_phase<pg8::EpiSwiGLU, pg8::StaticOrder, true, true>(lds, g, S, E);
        }
        SEAM(pb + 0);
        if (IN_PH(pb + 1)) {
            pg8::Gemm g{HID, (const bf16_t*)(wl + WO_D1), M, DM, DFF}; pg8::StaticOrder S; S.init(M, DM, G, (int)blockIdx.x);
            pg8::EpiResid E{l == 0 ? args.in[0] : nullptr, XN, 0.5f, l == 0 ? nullptr : st_prev, l == 0 ? nullptr : args.in[25] + (l - 1) * DM, st_mix, nullptr, nullptr};
            pg8::gemm_phase<pg8::EpiResid, pg8::StaticOrder, true, true>(lds, g, S, E);
        }
        SEAM(pb + 1);
        if (IN_PH(pb + 2)) {
            { pg8::Gemm g{XN, (const bf16_t*)(wl + WO_IN), M, 1792, DM}; pg8::StaticOrder S; S.init(M, 1792, G, (int)blockIdx.x);
              pg8::EpiIn E{Zb, UPb, Qb, Kb, args.in[13] + l * HD, args.in[14] + l * HD, st_mix};
              pg8::gemm_phase<pg8::EpiIn, pg8::StaticOrder, true, true>(lds, g, S, E); }
            { pg8::Gemm g{(const bf16_t*)(wl + WO_IN) + (size_t)1792 * DM, XN, 512, M, DM}; pg8::StaticOrder S; S.init(512, M, G, (int)((blockIdx.x + G / 2) % G));
              pg8::EpiBf16 E{Vt, VT_PITCH, st_mix};
              pg8::gemm_phase<pg8::EpiBf16, pg8::StaticOrder, true, true>(lds, g, S, E); }
        }
        SEAM(pb + 2);
        if (IN_PH(pb + 3)) {
            float lam;
            { const float a = args.in[15][l * HD + lane] * args.in[16][l * HD + lane], bq = args.in[17][l * HD + lane] * args.in[18][l * HD + lane];
              lam = __expf(wave_sum(a)) - __expf(wave_sum(bq)) + lambda_init;
              lam = __builtin_bit_cast(float, __builtin_amdgcn_readfirstlane(__builtin_bit_cast(int, lam))); }
            float wthr;
            { float gq = __builtin_fabsf(args.in[13][l * HD + lane]), gk = __builtin_fabsf(args.in[14][l * HD + lane]);
#pragma unroll
              for (int o = 1; o < 64; o <<= 1) { gq = __builtin_fmaxf(gq, __shfl_xor(gq, o)); gk = __builtin_fmaxf(gk, __shfl_xor(gk, o)); }
              const float b2 = 8.0f * gq * gk * LOG2E * 1.03f;
              wthr = 2.0f * b2 + 14.0f + 25.0f;
              wthr = __builtin_bit_cast(float, __builtin_amdgcn_readfirstlane(__builtin_bit_cast(int, wthr))); }
            const float wthr1 = 0.5f * (wthr - 39.0f) + 39.0f;
            const unsigned myq = xb_xcc_id() & 7u;
            unsigned qoff = 0;
            for (;;) {
                if (tid == 0) {
                    int got = -1;
                    while (qoff < 8u) {
                        const unsigned q = (myq + qoff) & 7u;
                        const unsigned i = atomicAdd(ctl + 4608 + l * 512 + q * 64, 1u);
                        if (i < 256u) { got = (int)(q * 256u + i); break; }
                        ++qoff;
                    }
                    misc[0] = got; misc[1] = (int)qoff;
                }
                __syncthreads();
                const int idx = misc[0]; qoff = (unsigned)misc[1];
                __syncthreads();
                if (idx < 0) break;
                const int qx = idx >> 8, li = idx & 255;
                if (li < 128) {
                    const int h = 3 - (li >> 5), gq = 32 * qx + (li & 31), b = gq >> 7, qb = gq & 127;
                    const float slope2 = exp2f(-2.0f * (float)(h + 1)) * LOG2E;
                    const float nlog = __builtin_fminf(14.0f, __builtin_amdgcn_logf(2.0f * (1.0f / (slope2 * 0.69314718f) + 1.0f)));
                    int W = SEQ;
                    if (!ATT_FULL) { const float wf = (wthr - 14.0f + nlog) / slope2 + 1.0f; W = wf < (float)SEQ ? (int)wf : SEQ; }
                    attn_unit(lds, Qb, Kb, Vt, Yb, b, h, qb, slope2, lam, args.in[19] + l * VD, l, W, wthr1 - 14.0f + nlog);
                } else if (li < 192) {
                    const int u = 64 * qx + (li - 128), b = u / (SEQ / 64), t0 = (u % (SEQ / 64)) * 64;
                    conv_unit(lds, Zb, Yb, b, t0, args.in[7] + l * 31 * 256, args.in[8] + l * 256, args.in[9] + l * 256, args.in[10] + l * 256);
                } else {
                    const int u = 64 * qx + (li - 192), b = u / (SEQ / 64), t0 = (u % (SEQ / 64)) * 64;
                    pool_unit(lds, UPb, Yb, b, t0, args.in[11] + l * 4 * 64 * 64, args.in[12] + l * 256);
                }
            }
        }
        SEAM(pb + 3);
        if (IN_PH(pb + 4)) {
            pg8::Gemm g{Yb, (const bf16_t*)(wl + WO_OUT), M, DM, DM}; pg8::StaticOrder S; S.init(M, DM, G, (int)blockIdx.x);
            pg8::EpiResid E{nullptr, XN, 1.0f, nullptr, nullptr, st_ffn2, nullptr, nullptr};
            pg8::gemm_phase<pg8::EpiResid, pg8::StaticOrder, true, true>(lds, g, S, E);
        }
        SEAM(pb + 4);
        if (IN_PH(pb + 5)) {
            pg8::Gemm g{XN, (const bf16_t*)(wl + WO_GU2), M, 2 * DFF, DM}; pg8::StaticOrder S; S.init(M, 2 * DFF, G, (int)blockIdx.x);
            pg8::EpiSwiGLU E{HID, DFF, st_ffn2, nullptr};
            pg8::gemm_phase<pg8::EpiSwiGLU, pg8::StaticOrder, true, true>(lds, g, S, E);
        }
        SEAM(pb + 5);
        if (IN_PH(pb + 6)) {
            pg8::Gemm g{HID, (const bf16_t*)(wl + WO_D2), M, DM, DFF}; pg8::StaticOrder S; S.init(M, DM, G, (int)blockIdx.x);
            pg8::EpiResid E{nullptr, XN, 0.5f, nullptr, nullptr, st_post, (l + 1 < NLAYER) ? st_post2 : nullptr, args.in[25] + l * DM};
            pg8::gemm_phase<pg8::EpiResid, pg8::StaticOrder, true, true>(lds, g, S, E);
        }
        SEAM(pb + 6);
    }
    if (IN_PH(NPHASE - 1)) {
        const float* stp = ST + (size_t)(3 + 4 * (NLAYER - 1)) * M * 16; const float* gp = args.in[25] + (NLAYER - 1) * DM;
        for (int m = gw; m < M; m += NGW) {
            int ln = lane; asm volatile("" : "+v"(ln));
            const float rs = __builtin_amdgcn_rsqf(row_ss(stp, m) * (1.0f / DM) + EPS);
            const u32x2* xr = (const u32x2*)(XN + (size_t)m * DM) + ln; f32x4* orow = (f32x4*)(X + (size_t)m * DM) + ln;
#pragma unroll
            for (int j = 0; j < 4; ++j) { const u32x2 w = xr[64 * j];
                const f32x4 v = (f32x4){__uint_as_float(w.x << 16), __uint_as_float(w.x & 0xffff0000u), __uint_as_float(w.y << 16), __uint_as_float(w.y & 0xffff0000u)};
                orow[64 * j] = v * rs * ((const f32x4*)gp)[ln + 64 * j]; }
        }
    }
}

extern "C" void kernel_launch(void* const* d_in, const int* in_sizes, int n_in, void* d_out, int out_size, void* d_ws, size_t ws_size, hipStream_t stream) {
    static int grid = 0;
    if (grid == 0) {
        if (n_in != 26 || in_sizes[0] != M * DM || out_size != M * DM || ws_size < WS_TOTAL) { fprintf(stderr, "kernel_launch: unexpected problem shape (n_in %d, ws %zu)\n", n_in, ws_size); grid = -1; return; }
        int dev = 0, cus = 0, per_cu = 0;
        hipGetDevice(&dev); hipDeviceGetAttribute(&cus, hipDeviceAttributeMultiprocessorCount, dev);
        if (hipFuncSetAttribute((const void*)fwd_kernel, hipFuncAttributeMaxDynamicSharedMemorySize, LDS_BYTES) != hipSuccess) { fprintf(stderr, "kernel_launch: hipFuncSetAttribute failed\n"); grid = -1; return; }
        if (hipOccupancyMaxActiveBlocksPerMultiprocessor(&per_cu, (const void*)fwd_kernel, 512, LDS_BYTES) != hipSuccess || per_cu < 1) { fprintf(stderr, "kernel_launch: occupancy query says %d\n", per_cu); per_cu = 1; }
        (void)hipGetLastError();
        grid = cus;
    }
    if (grid < 0) return;
    Args a{};
    for (int i = 0; i < 26; ++i) a.in[i] = (const float*)d_in[i];
    a.out = (float*)d_out; a.ws = (unsigned char*)d_ws;
#if MK_SINGLE
    a.ph_lo = 0; a.ph_hi = NPHASE;
    void* kargs[] = {&a};
    hipError_t e = hipLaunchCooperativeKernel((const void*)fwd_kernel, dim3(grid), dim3(512), kargs, LDS_BYTES, stream);
    if (e != hipSuccess) fprintf(stderr, "cooperative launch failed: %s (grid %d)\n", hipGetErrorString(e), grid);
#else
    for (int p = 0; p < NPHASE; ++p) { a.ph_lo = p; a.ph_hi = p + 1; hipLaunchKernelGGL(fwd_kernel, dim3(grid), dim3(512), LDS_BYTES, stream, a); }
#endif
}
```
